# Optimizing an MI355X kernel written in HIP

```python
import math
import numpy as np
import jax
import jax.numpy as jnp
from jax import lax

D_MODEL = 1024
BATCH = 1
SEQ = 16384
DEPTH = 4

EPS = 1e-6
N_BRANCH = 3
BRANCH_WIDTH = 512
SSM_HEADS = 8
SSM_HEAD_DIM = 64
SSM_INNER = 512
SSM_GROUPS = 2
SSM_STATE = 128
SSM_CONV = 4
SSD_CHUNK = 128
SSM_XBC = SSM_INNER + 2 * SSM_GROUPS * SSM_STATE
SB_HEADS = 4
SB_HEAD_DIM = 128
SB_INNER = 512
SB_BLOCK = 128
GDN_HEADS = 4
GDN_HEAD_DIM = 128
GDN_INNER = 512
GDN_CONV = 4
GDN_CHUNK = 64
MOE_GROUPS = 4
EXPERTS_PER_GROUP = 8
N_EXPERTS = 32
MOE_TOP_K = 2
EXPERT_FF = 512
MOE_BLOCK = 128
IN_SPLITS = (SSM_INNER, SSM_XBC, SSM_HEADS, 3 * SB_INNER, 3 * GDN_INNER, GDN_HEADS, GDN_HEADS, GDN_INNER, N_BRANCH * D_MODEL)
IN_COLS = SSM_INNER + SSM_XBC + SSM_HEADS + 3 * SB_INNER + 3 * GDN_INNER + 2 * GDN_HEADS + GDN_INNER + N_BRANCH * D_MODEL

kernel_name = "hybrid_ssd_stickbreak_gdn_hmoe"


def rms_norm(x, g):
    xf = x.astype(jnp.float32)
    y = xf * lax.rsqrt(jnp.mean(xf * xf, axis=-1, keepdims=True) + EPS)
    return (y * g.astype(jnp.float32)).astype(x.dtype)


def l2_norm(x):
    xf = x.astype(jnp.float32)
    return xf * lax.rsqrt(jnp.sum(xf * xf, axis=-1, keepdims=True) + EPS)


def causal_conv(x, w, b=None):
    k, ch = w.shape
    y = lax.conv_general_dilated(x, w[:, None, :].astype(x.dtype), window_strides=(1,), padding=[(k - 1, 0)],
                                 dimension_numbers=("NWC", "WIO", "NWC"), feature_group_count=ch)
    if b is not None:
        y = y + b.astype(x.dtype)
    return y


def ssd_chunked(xs, dt, a, bm, cm):
    bsz, s, h, p = xs.shape
    n = bm.shape[-1]
    nc = s // SSD_CHUNK
    xdt = (xs * dt[..., None]).reshape(bsz, nc, SSD_CHUNK, h, p)
    adt = (dt * a).reshape(bsz, nc, SSD_CHUNK, h).transpose(0, 3, 1, 2)
    bm = bm.reshape(bsz, nc, SSD_CHUNK, h, n)
    cm = cm.reshape(bsz, nc, SSD_CHUNK, h, n)
    a_cum = jnp.cumsum(adt, axis=-1)
    tril = jnp.tril(jnp.ones((SSD_CHUNK, SSD_CHUNK), bool))
    seg = jnp.exp(jnp.where(tril, a_cum[..., :, None] - a_cum[..., None, :], -jnp.inf))
    scores = jnp.einsum("bclhn,bcshn->bhcls", cm, bm) * seg
    y_diag = jnp.einsum("bhcls,bcshp->bclhp", scores, xdt)
    decay_states = jnp.exp(a_cum[..., -1:] - a_cum).transpose(0, 2, 3, 1)
    states = jnp.einsum("bclhn,bclhp->bchpn", bm, xdt * decay_states[..., None])
    chunk_decay = jnp.exp(a_cum[..., -1])

    def step(hstate, inp):
        st, dec = inp
        return hstate * dec[..., None, None] + st, hstate

    h0 = jnp.zeros((bsz, h, p, n), xs.dtype)
    _, states_in = lax.scan(step, h0, (states.transpose(1, 0, 2, 3, 4), chunk_decay.transpose(2, 0, 1)))
    states_in = states_in.transpose(1, 0, 2, 3, 4)
    c_dec = cm * jnp.exp(a_cum).transpose(0, 2, 3, 1)[..., None]
    y_off = jnp.einsum("bclhn,bchpn->bclhp", c_dec, states_in)
    return (y_diag + y_off).reshape(bsz, s, h, p)


def mamba2_branch(z, xbc, dt_raw, conv_w, conv_b, dt_bias, a_log, d_skip, norm_g):
    bsz, s, _ = z.shape
    xbc = jax.nn.silu(causal_conv(xbc, conv_w, conv_b)).astype(jnp.float32)
    xs, bm, cm = jnp.split(xbc, [SSM_INNER, SSM_INNER + SSM_GROUPS * SSM_STATE], axis=-1)
    xs = xs.reshape(bsz, s, SSM_HEADS, SSM_HEAD_DIM)
    rep = SSM_HEADS // SSM_GROUPS
    bm = jnp.repeat(bm.reshape(bsz, s, SSM_GROUPS, SSM_STATE), rep, axis=2)
    cm = jnp.repeat(cm.reshape(bsz, s, SSM_GROUPS, SSM_STATE), rep, axis=2)
    dt = jax.nn.softplus(dt_raw.astype(jnp.float32) + dt_bias.astype(jnp.float32))
    a = -jnp.exp(a_log.astype(jnp.float32))
    y = ssd_chunked(xs, dt, a, bm, cm) + xs * d_skip.astype(jnp.float32)[:, None]
    gsz = SSM_INNER // SSM_GROUPS
    y = y.reshape(bsz, s, SSM_GROUPS, gsz) * jax.nn.silu(z.astype(jnp.float32)).reshape(bsz, s, SSM_GROUPS, gsz)
    y = rms_norm(y, norm_g.reshape(SSM_GROUPS, gsz))
    return y.reshape(bsz, s, SSM_INNER)


def stick_breaking_attention(q, k, v):
    bsz, s, h, d = q.shape
    nblk = s // SB_BLOCK
    blk = SB_BLOCK

    def to_blocks(t):
        return t.astype(jnp.float32).reshape(bsz, nblk, blk, h, d).transpose(0, 3, 1, 2, 4)

    qb = to_blocks(q) * (d ** -0.5)
    kb = to_blocks(k)
    vb = to_blocks(v)
    idx = jnp.arange(blk)
    suffix = (idx[:, None] > idx[None, :]).astype(jnp.float32)
    diag_mask = idx[None, :] < idx[:, None]
    acc = jnp.zeros((bsz, h, nblk, blk), jnp.float32)
    out = jnp.zeros((bsz, h, nblk, blk, d), jnp.float32)
    for o in range(nblk):
        n = nblk - o
        z = jnp.einsum("bhnqd,bhnkd->bhnqk", qb[:, :, o:], kb[:, :, :n])
        log_beta = jax.nn.log_sigmoid(z)
        log_keep = log_beta - z
        if o == 0:
            log_keep = jnp.where(diag_mask, log_keep, 0.0)
        after = jnp.einsum("bhnqj,js->bhnqs", log_keep, suffix) + acc[:, :, o:, :, None]
        att = jnp.exp(log_beta + after)
        if o == 0:
            att = jnp.where(diag_mask, att, 0.0)
        out = out.at[:, :, o:].add(jnp.einsum("bhnqk,bhnkd->bhnqd", att, vb[:, :, :n]))
        acc = acc.at[:, :, o:].add(jnp.sum(log_keep, axis=-1))
    return out.transpose(0, 2, 3, 1, 4).reshape(bsz, s, h, d)


def stick_breaking_branch(qkv, q_norm_g, k_norm_g):
    bsz, s, _ = qkv.shape
    q, k, v = [t.reshape(bsz, s, SB_HEADS, SB_HEAD_DIM) for t in jnp.split(qkv, 3, axis=-1)]
    q = rms_norm(q, q_norm_g)
    k = rms_norm(k, k_norm_g)
    return stick_breaking_attention(q, k, v).reshape(bsz, s, SB_INNER)


def gated_delta_chunked(q, k, v, g, beta):
    bsz, s, h, dk = q.shape
    dv = v.shape[-1]
    nc = s // GDN_CHUNK
    cs = GDN_CHUNK

    def to_chunks(t):
        return t.reshape(bsz, nc, cs, h, t.shape[-1]).transpose(0, 3, 1, 2, 4)

    q = to_chunks(q * dk ** -0.5)
    k = to_chunks(k)
    v = to_chunks(v)
    g = g.reshape(bsz, nc, cs, h).transpose(0, 3, 1, 2)
    beta = beta.reshape(bsz, nc, cs, h).transpose(0, 3, 1, 2)
    g_cum = jnp.cumsum(g, axis=-1)
    tril_incl = jnp.tril(jnp.ones((cs, cs), bool))
    strict = jnp.tril(jnp.ones((cs, cs), bool), k=-1)
    decay = jnp.exp(jnp.where(tril_incl, g_cum[..., :, None] - g_cum[..., None, :], -jnp.inf))
    k_beta = k * beta[..., None]
    v_beta = v * beta[..., None]
    m = jnp.where(strict, jnp.einsum("bhncd,bhnsd->bhncs", k_beta, k) * decay, 0.0)
    t_mat = m + jnp.eye(cs, dtype=m.dtype)
    rhs = jnp.concatenate([v_beta, k_beta * jnp.exp(g_cum)[..., None]], axis=-1)
    sol = lax.linalg.triangular_solve(t_mat, rhs, left_side=True, lower=True, unit_diagonal=True)
    u, w = sol[..., :dv], sol[..., dv:]
    attn = jnp.where(tril_incl, jnp.einsum("bhncd,bhnsd->bhncs", q, k) * decay, 0.0)
    q_dec = q * jnp.exp(g_cum)[..., None]
    k_dec = k * jnp.exp(g_cum[..., -1:] - g_cum)[..., None]
    chunk_dec = jnp.exp(g_cum[..., -1])

    def step(state, inp):
        qd, kd, u_c, w_c, a_c, dec = inp
        v_new = u_c - jnp.einsum("bhcd,bhde->bhce", w_c, state)
        o = jnp.einsum("bhcd,bhde->bhce", qd, state) + jnp.einsum("bhcs,bhse->bhce", a_c, v_new)
        state = state * dec[..., None, None] + jnp.einsum("bhcd,bhce->bhde", kd, v_new)
        return state, o

    front = lambda t: t.transpose(2, 0, 1, 3, 4)
    s0 = jnp.zeros((bsz, h, dk, dv), q.dtype)
    _, o = lax.scan(step, s0, (front(q_dec), front(k_dec), front(u), front(w), front(attn), chunk_dec.transpose(2, 0, 1)))
    return o.transpose(1, 0, 3, 2, 4).reshape(bsz, s, h, dv)


def gated_deltanet_branch(qkv, a_raw, b_raw, gate, conv_w, a_log, dt_bias, norm_g):
    bsz, s, _ = qkv.shape
    qkv = jax.nn.silu(causal_conv(qkv, conv_w)).astype(jnp.float32)
    q, k, v = [t.reshape(bsz, s, GDN_HEADS, GDN_HEAD_DIM) for t in jnp.split(qkv, 3, axis=-1)]
    q = l2_norm(q)
    k = l2_norm(k)
    beta = jax.nn.sigmoid(b_raw.astype(jnp.float32))
    g = -jnp.exp(a_log.astype(jnp.float32)) * jax.nn.softplus(a_raw.astype(jnp.float32) + dt_bias.astype(jnp.float32))
    o = gated_delta_chunked(q, k, v, g, beta)
    o = rms_norm(o, norm_g) * jax.nn.silu(gate.astype(jnp.float32).reshape(bsz, s, GDN_HEADS, GDN_HEAD_DIM))
    return o.reshape(bsz, s, GDN_INNER)


def hier_moe(h, w_group, b_group, w_router, b_router, w_gate, w_up, w_down):
    n, d = h.shape
    hf = h.astype(jnp.float32)
    group_logits = hf @ w_group.astype(jnp.float32) + b_group.astype(jnp.float32)
    group_prob = jax.nn.softmax(group_logits, axis=-1)
    g_sel = jnp.argmax(group_logits, axis=-1)
    p_group = jnp.take_along_axis(group_prob, g_sel[:, None], axis=1)[:, 0]
    exp_logits = (hf @ w_router.astype(jnp.float32) + b_router.astype(jnp.float32)).reshape(n, MOE_GROUPS, EXPERTS_PER_GROUP)
    in_group = jnp.take_along_axis(exp_logits, g_sel[:, None, None], axis=1)[:, 0]
    top_p, top_i = lax.top_k(jax.nn.softmax(in_group, axis=-1), MOE_TOP_K)
    weights = p_group[:, None] * top_p / jnp.sum(top_p, axis=-1, keepdims=True)
    expert_ids = (g_sel[:, None] * EXPERTS_PER_GROUP + top_i).astype(jnp.int32)
    m = n * MOE_TOP_K
    flat_e = expert_ids.reshape(m)
    flat_tok = jnp.repeat(jnp.arange(n, dtype=jnp.int32), MOE_TOP_K)
    flat_w = weights.reshape(m)
    order = jnp.argsort(flat_e)
    sorted_e = flat_e[order]
    counts = jnp.zeros((N_EXPERTS,), jnp.int32).at[flat_e].add(1)
    padded = (counts + MOE_BLOCK - 1) // MOE_BLOCK * MOE_BLOCK
    start = jnp.cumsum(counts) - counts
    pend = jnp.cumsum(padded)
    pstart = pend - padded
    dest = pstart[sorted_e] + (jnp.arange(m, dtype=jnp.int32) - start[sorted_e])
    n_blocks = -(-m // MOE_BLOCK) + N_EXPERTS
    slot_tok = jnp.full((n_blocks * MOE_BLOCK,), n, jnp.int32).at[dest].set(flat_tok[order])
    slot_w = jnp.zeros((n_blocks * MOE_BLOCK,), jnp.float32).at[dest].set(flat_w[order])
    block_expert = jnp.minimum(jnp.searchsorted(pend, jnp.arange(n_blocks, dtype=jnp.int32) * MOE_BLOCK, side="right"), N_EXPERTS - 1)
    h_pad = jnp.concatenate([h, jnp.zeros((1, d), h.dtype)], axis=0)
    xb = h_pad[slot_tok].reshape(n_blocks, MOE_BLOCK, d)

    def expert_block(args):
        xi, e = args
        return (jax.nn.silu(xi @ w_gate[e]) * (xi @ w_up[e])) @ w_down[e]

    yb = lax.map(expert_block, (xb, block_expert)).reshape(n_blocks * MOE_BLOCK, d)
    y = jax.ops.segment_sum(yb * slot_w[:, None].astype(yb.dtype), slot_tok, num_segments=n + 1)
    return y[:n]


def setup_inputs(seed: int = 0) -> dict:
    key = jax.random.key(seed)
    ks = jax.random.split(key, 32)
    f32 = jnp.float32
    L, D = DEPTH, D_MODEL

    def nrm(k, shape, scale):
        return jax.random.normal(k, shape, f32) * scale

    def gain(k, shape):
        return 1.0 + 0.02 * jax.random.normal(k, shape, f32)

    def dt_bias_init(k, shape):
        dt = jnp.exp(jax.random.uniform(k, shape, f32, math.log(1e-3), math.log(1e-1)))
        return dt + jnp.log(-jnp.expm1(-dt))

    return {
        "x": nrm(ks[0], (BATCH, SEQ, D), 1.0),
        "c": nrm(ks[1], (BATCH, D), 1.0),
        "w_ada": nrm(ks[2], (L, D, 6 * D), 0.5 * D ** -0.5),
        "b_ada": nrm(ks[3], (L, 6 * D), 0.02),
        "norm_mix": gain(ks[4], (L, D)),
        "norm_ffn": gain(ks[5], (L, D)),
        "w_in": nrm(ks[6], (L, D, IN_COLS), D ** -0.5),
        "ssm_conv_w": nrm(ks[7], (L, SSM_CONV, SSM_XBC), SSM_CONV ** -0.5),
        "ssm_conv_b": nrm(ks[8], (L, SSM_XBC), 0.01),
        "ssm_dt_bias": dt_bias_init(ks[9], (L, SSM_HEADS)),
        "ssm_a_log": jnp.log(jax.random.uniform(ks[10], (L, SSM_HEADS), f32, 1.0, 16.0)),
        "ssm_d": gain(ks[11], (L, SSM_HEADS)),
        "ssm_norm": gain(ks[12], (L, SSM_INNER)),
        "sb_q_norm": gain(ks[13], (L, SB_HEAD_DIM)),
        "sb_k_norm": gain(ks[14], (L, SB_HEAD_DIM)),
        "gdn_conv_w": nrm(ks[15], (L, GDN_CONV, 3 * GDN_INNER), GDN_CONV ** -0.5),
        "gdn_a_log": jnp.log(jax.random.uniform(ks[16], (L, GDN_HEADS), f32, 1.0, 16.0)),
        "gdn_dt_bias": dt_bias_init(ks[17], (L, GDN_HEADS)),
        "gdn_norm": gain(ks[18], (L, GDN_HEAD_DIM)),
        "w_branch": nrm(ks[19], (L, N_BRANCH, BRANCH_WIDTH, D), BRANCH_WIDTH ** -0.5),
        "w_out": nrm(ks[20], (L, D, D), D ** -0.5),
        "w_group": nrm(ks[21], (L, D, MOE_GROUPS), D ** -0.5),
        "b_group": nrm(ks[22], (L, MOE_GROUPS), 0.01),
        "w_router": nrm(ks[23], (L, D, N_EXPERTS), D ** -0.5),
        "b_router": nrm(ks[24], (L, N_EXPERTS), 0.01),
        "w_gate": nrm(ks[25], (L, N_EXPERTS, D, EXPERT_FF), D ** -0.5),
        "w_up": nrm(ks[26], (L, N_EXPERTS, D, EXPERT_FF), D ** -0.5),
        "w_down": nrm(ks[27], (L, N_EXPERTS, EXPERT_FF, D), EXPERT_FF ** -0.5),
    }


def reference(x, c, w_ada, b_ada, norm_mix, norm_ffn, w_in, ssm_conv_w, ssm_conv_b, ssm_dt_bias, ssm_a_log, ssm_d,
              ssm_norm, sb_q_norm, sb_k_norm, gdn_conv_w, gdn_a_log, gdn_dt_bias, gdn_norm, w_branch, w_out,
              w_group, b_group, w_router, b_router, w_gate, w_up, w_down):
    bsz, s, d = x.shape
    split_points = np.cumsum(IN_SPLITS)[:-1].tolist()
    c_act = jax.nn.silu(c)
    for l in range(DEPTH):
        mod = c_act @ w_ada[l] + b_ada[l]
        shift_m, scale_m, gate_m, shift_f, scale_f, gate_f = [t[:, None, :] for t in jnp.split(mod, 6, axis=-1)]
        h = rms_norm(x, norm_mix[l]) * (1.0 + scale_m) + shift_m
        proj = h @ w_in[l]
        m_z, m_xbc, m_dt, sb_qkv, g_qkv, g_a, g_b, g_gate, br_gate = jnp.split(proj, split_points, axis=-1)
        y_a = mamba2_branch(m_z, m_xbc, m_dt, ssm_conv_w[l], ssm_conv_b[l], ssm_dt_bias[l], ssm_a_log[l], ssm_d[l], ssm_norm[l])
        y_b = stick_breaking_branch(sb_qkv, sb_q_norm[l], sb_k_norm[l])
        y_c = gated_deltanet_branch(g_qkv, g_a, g_b, g_gate, gdn_conv_w[l], gdn_a_log[l], gdn_dt_bias[l], gdn_norm[l])
        branches = jnp.stack([y_a.astype(x.dtype), y_b.astype(x.dtype), y_c.astype(x.dtype)], axis=2)
        branch_proj = jnp.einsum("bsie,ied->bsid", branches, w_branch[l])
        gates = jax.nn.sigmoid(br_gate.astype(jnp.float32)).astype(x.dtype).reshape(bsz, s, N_BRANCH, d)
        merged = jnp.sum(gates * branch_proj, axis=2)
        x = x + gate_m * (merged @ w_out[l])
        h = rms_norm(x, norm_ffn[l]) * (1.0 + scale_f) + shift_f
        y = hier_moe(h.reshape(bsz * s, d), w_group[l], b_group[l], w_router[l], b_router[l], w_gate[l], w_up[l], w_down[l])
        x = x + gate_f * y.reshape(bsz, s, d)
    return x
```

```cpp
#include <hip/hip_runtime.h>
#include <cstdio>
#include <cstdint>

#ifndef MK_SPLIT
#define MK_SPLIT 0
#endif

namespace pg8 {
#define PG8_LAS __attribute__((address_space(3)))
typedef unsigned short bf16_t;
typedef short bf16x8 __attribute__((ext_vector_type(8)));
typedef float f32x4 __attribute__((ext_vector_type(4)));
typedef unsigned u32x4 __attribute__((ext_vector_type(4)));
typedef unsigned u32x2 __attribute__((ext_vector_type(2)));
constexpr int BM = 256, BK = 64, HALF = 128, HTB = HALF * BK * 2, STAGE_BYTES = 8 * HTB, NXCD = 8, WGM = 8;

__host__ __device__ __forceinline__ int lds_byte(int r, int c) { const int st = (r >> 4) * 2 + (c >> 5), rr = r & 15, cc = c & 31, ob = rr * 64 + cc * 2; return st * 1024 + (ob ^ (((ob >> 9) & 1) << 5)); }
__host__ __device__ __forceinline__ void stage_rc(int b, int& R, int& C) { const int st = b / 1024, sb = b % 1024, swz = sb ^ (((sb >> 9) & 1) << 5); R = (st >> 1) * 16 + swz / 64; C = (st & 1) * 32 + (swz % 64) / 2; }
__host__ __device__ __forceinline__ int perm32(int rho) { const int n = rho >> 4, i = rho & 15; return 8 * (i >> 2) + 4 * n + (i & 3); }

struct Unit { int pm, pn, z; };
struct Gemm { const bf16_t* A; const bf16_t* Bt; int K; size_t zsA, zsB; };

struct StaticOrder {
    int nM, nN, nwg, G, c;
    __host__ __device__ void init(int M, int N, int G_, int c_) { nM = M / BM; nN = N / BM; nwg = nM * nN; G = G_; c = c_; }
    __host__ __device__ bool map(long L, Unit& u) const {
        if (L >= nwg) return false;
        int wgid = (int)L; { const int q = nwg / NXCD, r = nwg % NXCD, xcd = wgid % NXCD, off = wgid / NXCD; wgid = (xcd < r ? xcd * (q + 1) : r * (q + 1) + (xcd - r) * q) + off; }
        const int nig = WGM * nN, gid = wgid / nig, fm = gid * WGM, gsz = (nM - fm) < WGM ? (nM - fm) : WGM;
        u.pm = fm + ((wgid % nig) % gsz); u.pn = (wgid % nig) / gsz; u.z = 0; return true;
    }
    __host__ __device__ bool next(int i, Unit& u) const { return map((long)i * G + c, u); }
};
struct BranchOrder {
    StaticOrder so;
    __device__ bool next(int i, Unit& u) const { const int rd = i / 3; const bool ok = so.map((long)rd * so.G + so.c, u); u.z = i - 3 * rd; return ok; }
};
struct ExpertOrder {
    const PG8_LAS int* tab; int G, c, ntiles;
    __device__ bool next(int i, Unit& u) const {
        const int L = i * G + c, rt = L >> 2; if (rt >= ntiles) return false;
        int e = 0; const PG8_LAS int* tb = tab; asm volatile("" : "+v"(tb));
        for (int k = 1; k < 32; ++k) e += (tb[k] <= rt) ? 1 : 0;
        e = __builtin_amdgcn_readfirstlane(e);
        u.pm = rt; u.pn = L & 3; u.z = e; return true;
    }
};

__device__ __forceinline__ unsigned cvt_pk_bf16(float lo, float hi) { unsigned r; asm volatile("v_cvt_pk_bf16_f32 %0, %1, %2" : "=v"(r) : "v"(lo), "v"(hi)); return r; }
__device__ __forceinline__ float fsigmoid(float x) { return __builtin_amdgcn_rcpf(1.0f + __expf(-x)); }

struct EpiProj {
    static constexpr bool PERM = true;
    __device__ __forceinline__ bool keep(const Unit&) const { return false; }
    bf16_t* O; int ldc; int sig_pn; bf16_t* gates;
    __device__ __forceinline__ void operator()(const f32x4 (&acc)[2][2][4][2], const Unit& u, int wr, int wc, int fr, int fq) const {
        const int row0 = u.pm * BM + wr * 64 + fr, col0 = u.pn * BM + wc * 32 + 8 * fq; const bool sg = u.pn >= sig_pn;
        if (!sg) {
#pragma unroll
            for (int ai = 0; ai < 2; ++ai)
#pragma unroll
                for (int m = 0; m < 4; ++m) { bf16_t* rowp = O + (size_t)(row0 + ai * HALF + m * 16) * ldc + col0;
#pragma unroll
                    for (int bj = 0; bj < 2; ++bj) { const f32x4 v0 = acc[ai][bj][m][0], v1 = acc[ai][bj][m][1];
                        u32x4 w; w.x = cvt_pk_bf16(v0[0], v0[1]); w.y = cvt_pk_bf16(v0[2], v0[3]); w.z = cvt_pk_bf16(v1[0], v1[1]); w.w = cvt_pk_bf16(v1[2], v1[3]);
                        *(u32x4*)(rowp + bj * HALF) = w; } }
        } else { const int z = (u.pn - sig_pn) >> 2, pq = (u.pn - sig_pn) & 3;
            bf16_t* gb = gates + ((((size_t)(z * 64 + u.pm) * 4 + pq) * 2 + wr) * 4 + wc) * 2 * 4 * 64 * 16 + (size_t)((2 * (fq & 1)) * 16 + fr) * 16 + (fq >> 1) * 4;
#pragma unroll
            for (int ai = 0; ai < 2; ++ai)
#pragma unroll
                for (int m = 0; m < 4; ++m)
#pragma unroll
                    for (int bj = 0; bj < 2; ++bj) { f32x4 v0 = acc[ai][bj][m][0], v1 = acc[ai][bj][m][1];
#pragma unroll
                        for (int j = 0; j < 4; ++j) { v0[j] = fsigmoid(v0[j]); v1[j] = fsigmoid(v1[j]); }
                        bf16_t* p = gb + (size_t)(ai * 4 + m) * 64 * 16 + bj * 8;
                        u32x2 w0, w1; w0.x = cvt_pk_bf16(v0[0], v0[1]); w0.y = cvt_pk_bf16(v0[2], v0[3]); w1.x = cvt_pk_bf16(v1[0], v1[1]); w1.y = cvt_pk_bf16(v1[2], v1[3]);
                        *(u32x2*)p = w0; *(u32x2*)(p + 16 * 16) = w1; } }
    }
};
struct EpiAct {
    static constexpr bool PERM = true;
    __device__ __forceinline__ bool keep(const Unit&) const { return false; }
    bf16_t* O;
    __device__ __forceinline__ void operator()(const f32x4 (&acc)[2][2][4][2], const Unit& u, int wr, int wc, int fr, int fq) const {
        const int row0 = u.pm * BM + wr * 64 + fr, col0 = u.pn * HALF + wc * 32 + 8 * fq;
#pragma unroll
        for (int ai = 0; ai < 2; ++ai)
#pragma unroll
            for (int m = 0; m < 4; ++m) { bf16_t* rowp = O + (size_t)(row0 + ai * HALF + m * 16) * 512 + col0;
                f32x4 a0, a1;
#pragma unroll
                for (int j = 0; j < 4; ++j) { const float g0 = acc[ai][0][m][0][j], g1 = acc[ai][0][m][1][j];
                    a0[j] = g0 * fsigmoid(g0) * acc[ai][1][m][0][j]; a1[j] = g1 * fsigmoid(g1) * acc[ai][1][m][1][j]; }
                u32x4 w; w.x = cvt_pk_bf16(a0[0], a0[1]); w.y = cvt_pk_bf16(a0[2], a0[3]); w.z = cvt_pk_bf16(a1[0], a1[1]); w.w = cvt_pk_bf16(a1[2], a1[3]);
                *(u32x4*)rowp = w; }
    }
};
struct EpiOut {
    static constexpr bool PERM = false;
    __device__ __forceinline__ bool keep(const Unit&) const { return false; }
    const float* base; float* out; const float* gate;
    __device__ __forceinline__ void operator()(const f32x4 (&acc)[2][2][4][2], const Unit& u, int wr, int wc, int fr, int fq) const {
        const int row0 = u.pm * BM + wr * 64 + fr, col0 = u.pn * BM + wc * 32 + 4 * fq;
        f32x4 gv[2][2];
#pragma unroll
        for (int bj = 0; bj < 2; ++bj)
#pragma unroll
            for (int n = 0; n < 2; ++n) gv[bj][n] = *(const f32x4*)(gate + col0 + bj * HALF + n * 16);
#pragma unroll
        for (int ai = 0; ai < 2; ++ai)
#pragma unroll
            for (int m = 0; m < 4; ++m) { const size_t off = (size_t)(row0 + ai * HALF + m * 16) * 1024 + col0;
#pragma unroll
                for (int bj = 0; bj < 2; ++bj)
#pragma unroll
                    for (int n = 0; n < 2; ++n) { const f32x4 b = *(const f32x4*)(base + off + bj * HALF + n * 16);
                        *(f32x4*)(out + off + bj * HALF + n * 16) = b + gv[bj][n] * acc[ai][bj][m][n]; }
                if (m & 1) asm volatile("" ::: "memory"); }
    }
};
struct EpiBranch {
    static constexpr bool PERM = false;
    const bf16_t* gates; bf16_t* merged;
    __device__ __forceinline__ bool keep(const Unit& u) const { return u.z < 2; }
    __device__ __forceinline__ void operator()(f32x4 (&acc)[2][2][4][2], const Unit& u, int wr, int wc, int fr, int fq) const {
        const int row0 = u.pm * BM + wr * 64 + fr, col0 = u.pn * BM + wc * 32 + 4 * fq; const float tiny = 8.673617379884035e-19f;
        const bf16_t* gb = gates + ((((size_t)(u.z * 64 + u.pm) * 4 + u.pn) * 2 + wr) * 4 + wc) * 2 * 4 * 64 * 16 + (size_t)(fq * 16 + fr) * 16;
        const size_t zs = (size_t)64 * 4 * 2 * 4 * 2 * 4 * 64 * 16;
#pragma unroll
        for (int ai = 0; ai < 2; ++ai)
#pragma unroll
            for (int m = 0; m < 4; ++m) { const size_t off = (size_t)(row0 + ai * HALF + m * 16) * 1024 + col0; const bf16_t* gp = gb + (size_t)(ai * 4 + m) * 64 * 16;
                const u32x4 ga = *(const u32x4*)gp, gbv = *(const u32x4*)(gp + 8); u32x4 ha = ga, hb = gbv;
                if (u.z < 2) { ha = *(const u32x4*)(gp + zs); hb = *(const u32x4*)(gp + zs + 8); }
                const unsigned gw[8] = {ga.x, ga.y, ga.z, ga.w, gbv.x, gbv.y, gbv.z, gbv.w}, hw[8] = {ha.x, ha.y, ha.z, ha.w, hb.x, hb.y, hb.z, hb.w};
#pragma unroll
                for (int bj = 0; bj < 2; ++bj)
#pragma unroll
                    for (int n = 0; n < 2; ++n) { const int q = (bj * 2 + n) * 2; const int co = bj * HALF + n * 16;
                        f32x4 g; g[0] = __uint_as_float(gw[q] << 16); g[1] = __uint_as_float(gw[q] & 0xffff0000u); g[2] = __uint_as_float(gw[q + 1] << 16); g[3] = __uint_as_float(gw[q + 1] & 0xffff0000u);
#pragma unroll
                        for (int j = 0; j < 4; ++j) g[j] = fmaxf(g[j], tiny);
                        if (u.z < 2) { f32x4 h; h[0] = __uint_as_float(hw[q] << 16); h[1] = __uint_as_float(hw[q] & 0xffff0000u); h[2] = __uint_as_float(hw[q + 1] << 16); h[3] = __uint_as_float(hw[q + 1] & 0xffff0000u);
#pragma unroll
                            for (int j = 0; j < 4; ++j) g[j] *= __builtin_amdgcn_rcpf(fmaxf(h[j], tiny));
                            acc[ai][bj][m][n] = acc[ai][bj][m][n] * g; }
                        else { const f32x4 t = acc[ai][bj][m][n] * g; u32x2 w; w.x = cvt_pk_bf16(t[0], t[1]); w.y = cvt_pk_bf16(t[2], t[3]); *(u32x2*)(merged + off + co) = w; } }
                if ((m & 3) == 3) asm volatile("" ::: "memory"); }
    }
};
struct EpiBf16 {
    static constexpr bool PERM = true;
    __device__ __forceinline__ bool keep(const Unit&) const { return false; }
    bf16_t* O;
    __device__ __forceinline__ void operator()(const f32x4 (&acc)[2][2][4][2], const Unit& u, int wr, int wc, int fr, int fq) const {
        const int row0 = u.pm * BM + wr * 64 + fr, col0 = u.pn * BM + wc * 32 + 8 * fq;
#pragma unroll
        for (int ai = 0; ai < 2; ++ai)
#pragma unroll
            for (int m = 0; m < 4; ++m) { bf16_t* rowp = O + (size_t)(row0 + ai * HALF + m * 16) * 1024 + col0;
#pragma unroll
                for (int bj = 0; bj < 2; ++bj) { const f32x4 v0 = acc[ai][bj][m][0], v1 = acc[ai][bj][m][1];
                    u32x4 w; w.x = cvt_pk_bf16(v0[0], v0[1]); w.y = cvt_pk_bf16(v0[2], v0[3]); w.z = cvt_pk_bf16(v1[0], v1[1]); w.w = cvt_pk_bf16(v1[2], v1[3]);
                    *(u32x4*)(rowp + bj * HALF) = w; } }
    }
};

struct Gather { const int* tokof; const PG8_LAS int* tab; const PG8_LAS int* cnt; };
template <class Epi, class Sched, bool GATHER = false>
__device__ __forceinline__ void gemm_phase(PG8_LAS unsigned char* lds, const Gemm g, const Sched& S, const Epi& E, const Gather G = Gather{nullptr, nullptr, nullptr}) {
    int tid_ = threadIdx.x; asm volatile("" : "+v"(tid_));
    const int tid = tid_, wid = __builtin_amdgcn_readfirstlane(tid >> 6), lane = tid & 63, wr = wid >> 2, wc = wid & 3, fr = lane & 15, fq = lane >> 4;
    const int K = g.K, nt = K / BK;
    unsigned voffA[2], voffB[2]; int gR[2]; unsigned gC[2];
#pragma unroll
    for (int i = 0; i < 2; ++i) { int R, C; stage_rc(tid * 16 + i * 8192, R, C); const int Rb = Epi::PERM ? ((R & ~31) + perm32(R & 31)) : R;
        voffA[i] = (unsigned)(R * K + C) * 2u; voffB[i] = (unsigned)(Rb * K + C) * 2u; gR[i] = R; gC[i] = (unsigned)C * 2u; }
    unsigned gA[2][2], gN[2][2];
#define PG8_GLOAD(dst, u) do { const int e_ = (u).z, base_ = ((u).pm - G.tab[e_]) * 256, cn_ = G.cnt[e_]; _Pragma("unroll") for (int h_ = 0; h_ < 2; ++h_) _Pragma("unroll") for (int i_ = 0; i_ < 2; ++i_) { \
        const int pos_ = base_ + h_ * 128 + gR[i_]; const int tk_ = pos_ < cn_ ? G.tokof[e_ * 16384 + pos_] : 0; dst[h_][i_] = (unsigned)tk_ * (unsigned)(K * 2) + gC[i_]; } } while (0)
    const size_t kstep = (size_t)(BK * 2);
    const size_t hstep = (size_t)HALF * K * 2;
    const size_t tstep = 2 * hstep;
    const unsigned ldsw = (unsigned)wid * 1024u;
    const int aoff = lds_byte(wr * 64 + fr, fq * 8), boff = lds_byte(wc * 32 + fr, fq * 8);
#define PG8_SA(b, h) (((b) * 2 + (h)) * HTB)
#define PG8_SB(b, h) ((4 + (b) * 2 + (h)) * HTB)
#define PG8_STAGE(bufoff, gbase, voff) do { _Pragma("unroll") for (int _i = 0; _i < 2; ++_i) \
        __builtin_amdgcn_global_load_lds((const unsigned*)((const char*)(gbase) + (voff)[_i]), (PG8_LAS unsigned*)(lds + (bufoff) + ldsw + _i * 8192), 16, 0, 0); } while (0)
#define PG8_LDA(dst, b, h) do { _Pragma("unroll") for (int m = 0; m < 4; ++m) _Pragma("unroll") for (int k = 0; k < 2; ++k) dst[m][k] = *(const PG8_LAS bf16x8*)(lds + PG8_SA(b, h) + aoff + m * 2048 + k * 1024); } while (0)
#define PG8_LDB(dst, b, h) do { _Pragma("unroll") for (int n = 0; n < 2; ++n) _Pragma("unroll") for (int k = 0; k < 2; ++k) dst[n][k] = *(const PG8_LAS bf16x8*)(lds + PG8_SB(b, h) + boff + n * 2048 + k * 1024); } while (0)
#define PG8_MMA(ai, bj, At, Bt) do { __builtin_amdgcn_s_setprio(1); _Pragma("unroll") for (int m = 0; m < 4; ++m) _Pragma("unroll") for (int n = 0; n < 2; ++n) _Pragma("unroll") for (int k = 0; k < 2; ++k) \
        acc[ai][bj][m][n] = __builtin_amdgcn_mfma_f32_16x16x32_bf16(Bt[n][k], At[m][k], acc[ai][bj][m][n], 0, 0, 0); __builtin_amdgcn_s_setprio(0); } while (0)
#define PG8_WAIT_V(n) asm volatile("s_waitcnt vmcnt(" #n ")" ::: "memory")
#define PG8_WAIT_L(n) asm volatile("s_waitcnt lgkmcnt(" #n ")" ::: "memory")
#define PG8_BAR __builtin_amdgcn_s_barrier()
#define PG8_SCHED __builtin_amdgcn_sched_barrier(0)
    Unit cur, nxt; int ui = 0;
    if (!S.next(0, cur)) return;
    f32x4 acc[2][2][4][2];
#pragma unroll
    for (int a = 0; a < 2; ++a)
#pragma unroll
        for (int b = 0; b < 2; ++b)
#pragma unroll
            for (int m = 0; m < 4; ++m)
#pragma unroll
                for (int n = 0; n < 2; ++n) acc[a][b][m][n] = (f32x4){0.f, 0.f, 0.f, 0.f};
    bf16x8 At[4][2], B0[2][2], B1[2][2];
    const char* cA = GATHER ? (const char*)g.A : (const char*)g.A + (size_t)cur.z * g.zsA + (size_t)cur.pm * tstep; const char* cB = (const char*)g.Bt + (size_t)cur.z * g.zsB + (size_t)cur.pn * tstep;
    const size_t hA = GATHER ? 0 : hstep;
    if (GATHER) { PG8_GLOAD(gA, cur); } else { gA[0][0] = voffA[0]; gA[0][1] = voffA[1]; gA[1][0] = voffA[0]; gA[1][1] = voffA[1]; }
#pragma unroll
    for (int h = 0; h < 2; ++h) { gN[h][0] = gA[h][0]; gN[h][1] = gA[h][1]; }
    PG8_STAGE(PG8_SB(0, 0), cB, voffB); PG8_STAGE(PG8_SB(0, 1), cB + hstep, voffB); PG8_STAGE(PG8_SA(0, 0), cA, gA[0]); PG8_STAGE(PG8_SA(0, 1), cA + hA, gA[1]);
    if (wr == 1) PG8_BAR;
    PG8_WAIT_V(2); PG8_BAR;
    PG8_STAGE(PG8_SB(1, 0), cB + kstep, voffB); PG8_STAGE(PG8_SA(1, 0), cA + kstep, gA[0]); PG8_STAGE(PG8_SB(1, 1), cB + hstep + kstep, voffB);
    PG8_WAIT_V(6); PG8_BAR;
    for (;;) {
        const bool has_next = S.next(ui + 1, nxt);
        if (GATHER && has_next) { PG8_GLOAD(gN, nxt); }
        const char* nA = GATHER ? cA : (has_next ? (const char*)g.A + (size_t)nxt.z * g.zsA + (size_t)nxt.pm * tstep : cA); const char* nB = has_next ? (const char*)g.Bt + (size_t)nxt.z * g.zsB + (size_t)nxt.pn * tstep : cB;
        for (int t = 0; t < nt; t += 2) {
            const bool last = (t == nt - 2);
            const char* a1 = cA + (size_t)(t + 1) * kstep;
            const char* a2 = last ? nA : cA + (size_t)(t + 2) * kstep; const char* b2 = last ? nB : cB + (size_t)(t + 2) * kstep;
            const char* a3 = a2 + kstep; const char* b3 = b2 + kstep;
            unsigned s0[2], s1[2];
            s0[0] = last ? gN[0][0] : gA[0][0]; s0[1] = last ? gN[0][1] : gA[0][1]; s1[0] = last ? gN[1][0] : gA[1][0]; s1[1] = last ? gN[1][1] : gA[1][1];
            PG8_LDB(B0, 0, 0); PG8_LDB(B1, 0, 1); PG8_SCHED; PG8_LDA(At, 0, 0); PG8_STAGE(PG8_SA(1, 1), a1 + hA, gA[1]);
            PG8_WAIT_V(8); PG8_WAIT_L(0); PG8_BAR; PG8_MMA(0, 0, At, B0); PG8_MMA(0, 1, At, B1); PG8_BAR; PG8_SCHED;
            PG8_LDA(At, 0, 1); PG8_STAGE(PG8_SB(0, 0), b2, voffB); PG8_STAGE(PG8_SB(0, 1), b2 + hstep, voffB); PG8_STAGE(PG8_SA(0, 0), a2, s0);
            PG8_WAIT_V(8); PG8_WAIT_L(0); PG8_BAR; PG8_MMA(1, 0, At, B0); PG8_MMA(1, 1, At, B1); PG8_BAR; PG8_SCHED;
            PG8_LDB(B0, 1, 0); PG8_LDB(B1, 1, 1); PG8_SCHED; PG8_LDA(At, 1, 0); PG8_STAGE(PG8_SA(0, 1), a2 + hA, s1);
            PG8_WAIT_V(8); PG8_WAIT_L(0); PG8_BAR; PG8_MMA(0, 0, At, B0); PG8_MMA(0, 1, At, B1); PG8_BAR; PG8_SCHED;
            PG8_LDA(At, 1, 1); PG8_STAGE(PG8_SB(1, 0), b3, voffB); PG8_STAGE(PG8_SB(1, 1), b3 + hstep, voffB); PG8_STAGE(PG8_SA(1, 0), a3, s0);
            PG8_WAIT_V(8); PG8_WAIT_L(0); PG8_BAR; PG8_MMA(1, 0, At, B0); PG8_MMA(1, 1, At, B1); PG8_BAR; PG8_SCHED;
        }
        if (wr == 0) PG8_BAR;
        E(acc, cur, wr, wc, fr, fq);
        if (!has_next) break;
        if (!E.keep(cur))
#pragma unroll
        for (int a = 0; a < 2; ++a)
#pragma unroll
            for (int b = 0; b < 2; ++b)
#pragma unroll
                for (int m = 0; m < 4; ++m)
#pragma unroll
                    for (int n = 0; n < 2; ++n) acc[a][b][m][n] = (f32x4){0.f, 0.f, 0.f, 0.f};
        cur = nxt; cA = nA; cB = nB; ++ui;
#pragma unroll
        for (int h = 0; h < 2; ++h) { gA[h][0] = gN[h][0]; gA[h][1] = gN[h][1]; }
        if (wr == 1) PG8_BAR;
    }
    PG8_WAIT_V(0);
    PG8_BAR;
#undef PG8_SA
#undef PG8_SB
#undef PG8_STAGE
#undef PG8_GLOAD
#undef PG8_LDA
#undef PG8_LDB
#undef PG8_MMA
#undef PG8_WAIT_V
#undef PG8_WAIT_L
#undef PG8_BAR
#undef PG8_SCHED
}
}

constexpr int SEQ = 16384, DM = 1024, NL = 4;
constexpr int NPROJ = 5120;
constexpr int C_Z = 0, C_XBC = 512, C_SBQKV = 1536, C_GQKV = 3072, C_GGATE = 4608, C_BRG = 5120;
constexpr int IN_COLS = 8208;
constexpr float EPS = 1e-6f;
constexpr int NSLOT = 40960;
constexpr int NWAVES = 8;

constexpr size_t MiB = 1u << 20;
constexpr size_t WS_CTL = 0, CTL_ZERO_BYTES = 1 * MiB;
constexpr size_t WS_MODP = 1 * MiB;
constexpr size_t WS_MODF = 1 * MiB + 896 * 1024;
constexpr size_t WS_WSM = 2 * MiB;
constexpr size_t WS_WRT = 3 * MiB;
constexpr size_t WS_PAIR = 4 * MiB;
constexpr size_t WS_TOKOF = 580 * MiB;
constexpr size_t WS_SMALL = 5 * MiB;
constexpr size_t WS_WIN = 8 * MiB;
constexpr size_t WS_WBR = 72 * MiB;
constexpr size_t WS_WOUT = 84 * MiB;
constexpr size_t WS_WGU = 92 * MiB;
constexpr size_t WS_WD = 348 * MiB;
constexpr size_t WS_HB = 476 * MiB;
constexpr size_t WS_YBR = 508 * MiB;
constexpr size_t WS_PROJ = 620 * MiB;
constexpr size_t WS_GATES = 780 * MiB;
constexpr size_t WS_ACT = 700 * MiB;
constexpr size_t WS_YP = 740 * MiB;
constexpr size_t WS_MERGED = 940 * MiB;
constexpr size_t WS_XBCB = 876 * MiB;
constexpr size_t WS_SST = 908 * MiB;
constexpr size_t WS_SHIN = 556 * MiB;
constexpr size_t WS_ACUM = 572 * MiB;
constexpr size_t WS_SDEC = 573 * MiB;
constexpr size_t WS_GQE = 588 * MiB;
constexpr size_t WS_GOU = 604 * MiB;
constexpr size_t WS_GAP = 940 * MiB;
constexpr size_t WS_GBT = 972 * MiB;
constexpr size_t WS_GST = 1004 * MiB;
constexpr size_t WS_GDEC = 7 * MiB + 512 * 1024;
constexpr size_t WS_GAP2 = 574 * MiB;
constexpr size_t WS_GBT2 = 576 * MiB;
constexpr size_t WS_GST2 = 578 * MiB;
constexpr size_t WS_END = 1036 * MiB;
constexpr int CW_TMO = 0;
constexpr int CW_BAR = 4096;
constexpr int CW_SBQ = 190000;
constexpr int CW_CNT = 200000;
constexpr int N_PHASES = 54;

constexpr int LDS_BYTES = 151552;
constexpr int MISC_OFF = 147456;

#define GAS __attribute__((address_space(1)))
#define LAS __attribute__((address_space(3)))
typedef unsigned short bf16;
typedef unsigned v4u __attribute__((ext_vector_type(4)));
typedef unsigned v2u __attribute__((ext_vector_type(2)));
typedef float f32x4 __attribute__((ext_vector_type(4)));
typedef float f32x2 __attribute__((ext_vector_type(2)));
__device__ __forceinline__ unsigned f2bf(float f) { unsigned u = __builtin_bit_cast(unsigned, f); return (u + 0x7fffu + ((u >> 16) & 1u)) >> 16; }
__device__ __forceinline__ unsigned pk2(float lo, float hi) { return f2bf(lo) | (f2bf(hi) << 16); }
__device__ __forceinline__ float bflo(unsigned u) { return __uint_as_float(u << 16); }
__device__ __forceinline__ float bfhi(unsigned u) { return __uint_as_float(u & 0xffff0000u); }
__device__ __forceinline__ void unpack8(const v4u u, float* f) { f[0] = bflo(u.x); f[1] = bfhi(u.x); f[2] = bflo(u.y); f[3] = bfhi(u.y); f[4] = bflo(u.z); f[5] = bfhi(u.z); f[6] = bflo(u.w); f[7] = bfhi(u.w); }
__device__ __forceinline__ float silu_f(float x) { return x * __builtin_amdgcn_rcpf(1.0f + __expf(-x)); }
__device__ __forceinline__ float sigmoid_f(float x) { return __builtin_amdgcn_rcpf(1.0f + __expf(-x)); }
__device__ __forceinline__ float softplus_f(float x) { return fmaxf(x, 0.f) + log1pf(__expf(-fabsf(x))); }
__device__ __forceinline__ float wave_sum(float v) {
#pragma unroll
    for (int o = 1; o < 64; o <<= 1) v += __shfl_xor(v, o);
    return v;
}

#define XB_TMO      128
#define XB_XCNT(j)  (256  + 64 * (j))
#define XB_XSUB(j)  (1280 + 64 * (j))
#define XB_XGEN(j)  (2304 + 64 * (j))
#define XB_TOP      3328
#define XB_TOPGEN   3392
#define XCD_BAR_WORDS 3456
#define XB_SPIN_CAP (1u << 18)
__device__ __forceinline__ unsigned xb_ld(unsigned* p)              { return __hip_atomic_load(p, __ATOMIC_RELAXED, __HIP_MEMORY_SCOPE_AGENT); }
__device__ __forceinline__ unsigned xb_add(unsigned* p, unsigned v) { return __hip_atomic_fetch_add(p, v, __ATOMIC_RELAXED, __HIP_MEMORY_SCOPE_AGENT); }
__device__ __forceinline__ unsigned xb_xcc_id() { return (unsigned)__builtin_amdgcn_s_getreg((3 << 11) | 20) & 0xFu; }
#define XB_SPIN(cond, bar) do { unsigned _sp = 0; while (cond) { __builtin_amdgcn_s_sleep(1); \
    if ((++_sp & 255u) == 0u) { if (xb_ld(&(bar)[XB_TMO])) break; if (_sp > XB_SPIN_CAP) { atomicAdd(&(bar)[XB_TMO], 1u); break; } } } } while (0)
struct XcdBarrier { unsigned* bar; unsigned x; volatile LAS unsigned* st; };
__device__ __forceinline__ XcdBarrier xcd_barrier_post(unsigned* bar, volatile LAS unsigned* st) {
    XcdBarrier b; b.bar = bar; b.x = xb_xcc_id(); b.st = st;
    if (threadIdx.x == 0) (void)xb_add(&bar[XB_XCNT(b.x)], 1u);
    return b;
}
__device__ __forceinline__ void xcd_barrier_complete(unsigned* bar, unsigned x, unsigned& nloc, unsigned& nx) {
    const unsigned G = gridDim.x * gridDim.y * gridDim.z;
    unsigned sum, cnt, mine, sp = 0u;
    for (;;) {
        sum = 0u; cnt = 0u; mine = 0u;
#pragma unroll
        for (unsigned j = 0; j < 16; ++j) { const unsigned c = xb_ld(&bar[XB_XCNT(j)]); sum += c; cnt += (c > 0u) ? 1u : 0u; mine = (j == x) ? c : mine; }
        if (sum == G) break;
        __builtin_amdgcn_s_sleep(1);
        if ((++sp & 255u) == 0u) { if (xb_ld(&bar[XB_TMO])) break; if (sp > XB_SPIN_CAP) { atomicAdd(&bar[XB_TMO], 1u); break; } }
    }
    nloc = mine > 0u ? mine : 1u; nx = cnt > 0u ? cnt : 1u;
}
__device__ __forceinline__ void xcd_barrier(const XcdBarrier& b) {
    asm volatile("s_waitcnt vmcnt(0)" ::: "memory");
    __syncthreads();
    if (threadIdx.x == 0) {
        unsigned* bar = b.bar;
        __builtin_amdgcn_s_waitcnt(0);
        unsigned nloc = b.st[0], nx = b.st[1];
        if (nloc == 0u) { xcd_barrier_complete(bar, b.x, nloc, nx); b.st[0] = nloc; b.st[1] = nx; }
        const unsigned old = xb_add(&bar[XB_XSUB(b.x)], 1u);
        const unsigned gen = old / nloc;
        if (old + 1u == (gen + 1u) * nloc) {
            __builtin_amdgcn_fence(__ATOMIC_RELEASE, "agent");
            asm volatile("s_waitcnt vmcnt(0)" ::: "memory");
            const unsigned og = xb_add(&bar[XB_TOP], 1u);
            const unsigned tg = og / nx;
            if (og + 1u == (tg + 1u) * nx) xb_add(&bar[XB_TOPGEN], 1u);
            else XB_SPIN(xb_ld(&bar[XB_TOPGEN]) == tg, bar);
            __builtin_amdgcn_fence(__ATOMIC_ACQUIRE, "agent");
            xb_add(&bar[XB_XGEN(b.x)], 1u);
            asm volatile("s_waitcnt vmcnt(0)" ::: "memory");
        } else {
            XB_SPIN(xb_ld(&bar[XB_XGEN(b.x)]) == gen, bar);
            __builtin_amdgcn_fence(__ATOMIC_ACQUIRE, "agent");
            asm volatile("s_waitcnt vmcnt(0)" ::: "memory");
        }
    }
    __syncthreads();
}

struct Frame {
    LAS unsigned char* lds;
    unsigned* ctl;
    int tid, lane, wave, vcu, G;
    const float* const* in;
    float* out;
    unsigned char* ws;
};
#define P_x F.in[0]
#define P_c F.in[1]
#define P_w_ada F.in[2]
#define P_b_ada F.in[3]
#define P_norm_mix F.in[4]
#define P_norm_ffn F.in[5]
#define P_w_in F.in[6]
#define P_ssm_conv_w F.in[7]
#define P_ssm_conv_b F.in[8]
#define P_ssm_dt_bias F.in[9]
#define P_ssm_a_log F.in[10]
#define P_ssm_d F.in[11]
#define P_ssm_norm F.in[12]
#define P_sb_q_norm F.in[13]
#define P_sb_k_norm F.in[14]
#define P_gdn_conv_w F.in[15]
#define P_gdn_a_log F.in[16]
#define P_gdn_dt_bias F.in[17]
#define P_gdn_norm F.in[18]
#define P_w_branch F.in[19]
#define P_w_out F.in[20]
#define P_w_group F.in[21]
#define P_b_group F.in[22]
#define P_w_router F.in[23]
#define P_b_router F.in[24]
#define P_w_gate F.in[25]
#define P_w_up F.in[26]
#define P_w_down F.in[27]
#define W_MODP ((float*)(F.ws + WS_MODP))
#define W_MODF ((float*)(F.ws + WS_MODF))
#define W_WSM ((float*)(F.ws + WS_WSM))
#define W_WRT ((float*)(F.ws + WS_WRT))
#define W_SMALL ((float*)(F.ws + WS_SMALL))
#define W_TOKOF ((int*)(F.ws + WS_TOKOF))
#define W_PAIRE ((int*)(F.ws + WS_PAIR))
#define W_PAIRS ((int*)(F.ws + WS_PAIR + 131072))
#define W_PAIRW ((float*)(F.ws + WS_PAIR + 262144))
#define W_WIN ((bf16*)(F.ws + WS_WIN))
#define W_WBR ((bf16*)(F.ws + WS_WBR))
#define W_WOUT ((bf16*)(F.ws + WS_WOUT))
#define W_WGU ((bf16*)(F.ws + WS_WGU))
#define W_WD ((bf16*)(F.ws + WS_WD))
#define W_HB ((bf16*)(F.ws + WS_HB))
#define W_YBR ((bf16*)(F.ws + WS_YBR))
#define W_PROJ ((bf16*)(F.ws + WS_PROJ))
#define W_GATES ((bf16*)(F.ws + WS_GATES))
#define W_ACT ((bf16*)(F.ws + WS_ACT))
#define W_YP ((bf16*)(F.ws + WS_YP))
#define W_MERGED ((bf16*)(F.ws + WS_MERGED))
#define W_XBCB ((bf16*)(F.ws + WS_XBCB))
#define W_SST ((float*)(F.ws + WS_SST))
#define W_SHIN ((bf16*)(F.ws + WS_SHIN))
#define W_ACUM ((float*)(F.ws + WS_ACUM))
#define W_SDEC ((float*)(F.ws + WS_SDEC))
#define W_GQE ((bf16*)(F.ws + WS_GQE))
#define W_GOU ((bf16*)(F.ws + WS_GOU))
#define W_GAP ((bf16*)(F.ws + WS_GAP))
#define W_GBT ((bf16*)(F.ws + WS_GBT))
#define W_GST ((bf16*)(F.ws + WS_GST))
#define W_GDEC ((float*)(F.ws + WS_GDEC))
#define W_GAP2 ((bf16*)(F.ws + WS_GAP2))
#define W_GBT2 ((bf16*)(F.ws + WS_GBT2))
#define W_GST2 ((bf16*)(F.ws + WS_GST2))


template <bool FIN>
__device__ __forceinline__ f32x4 modv4(const Frame& F, int l, int seg, int col) {
    const int o = l * 6144 + seg * 1024 + col;
    f32x4 a;
    if (FIN) a = *(const f32x4*)(W_MODF + o);
    else { a = *(const f32x4*)(P_b_ada + o);
#pragma unroll
        for (int k = 0; k < 8; ++k) a += *(const f32x4*)(W_MODP + (size_t)k * 24576 + o); }
    asm volatile("" : "+v"(a) :: "memory");
    return a;
}

__device__ __forceinline__ void transpose_item(const float* W, int ldw, bf16* WT, int ldt, int k0, LAS float* scr, int lane) {
    float tv[32];
#pragma unroll
    for (int i = 0; i < 32; ++i) tv[i] = W[(size_t)(k0 + 2 * i + (lane >> 5)) * ldw + (lane & 31)];
#pragma unroll
    for (int i = 0; i < 32; ++i) scr[(2 * i + (lane >> 5)) * 33 + (lane & 31)] = tv[i];
    asm volatile("s_waitcnt lgkmcnt(0)" ::: "memory");
    const int c = lane & 7;
#pragma unroll
    for (int j = 0; j < 4; ++j) { const int n = (lane >> 3) + 8 * j; const LAS float* s = scr + (8 * c) * 33 + n;
        v4u o; o.x = pk2(s[0 * 33], s[1 * 33]); o.y = pk2(s[2 * 33], s[3 * 33]); o.z = pk2(s[4 * 33], s[5 * 33]); o.w = pk2(s[6 * 33], s[7 * 33]);
        *(v4u*)(WT + (size_t)n * ldt + k0 + 8 * c) = o; }
    asm volatile("s_waitcnt lgkmcnt(0)" ::: "memory");
}
__device__ __forceinline__ void p0_prologue(Frame& F) {
    LAS float* scr = (LAS float*)(F.lds + F.wave * 16384);
    const int gw = F.vcu * NWAVES + F.wave, NGW = F.G * NWAVES, lane = F.lane;
    constexpr int N_MOD = 768, N_WIN = 16384, N_BR = 3072, N_OUT = 2048, N_GU = 65536, N_DN = 32768;
    for (int it = gw; it < N_MOD + N_WIN + N_BR + N_OUT + N_GU + N_DN; it += NGW) {
        int r = it;
        if (r < N_MOD) {
            const int l = r / 192, rr = r % 192, cg = rr >> 3, kc = rr & 7, col = cg * 256 + 4 * lane;
            const float* w = P_w_ada + ((size_t)l * 1024 + kc * 128) * 6144 + col; f32x4 acc = (f32x4){0.f, 0.f, 0.f, 0.f};
#pragma unroll 8
            for (int k = 0; k < 128; ++k) { const float cv = P_c[kc * 128 + k]; acc += silu_f(cv) * *(const f32x4*)(w + (size_t)k * 6144); }
            *(f32x4*)(W_MODP + (size_t)kc * 24576 + l * 6144 + col) = acc; continue; }
        r -= N_MOD;
        if (r < N_WIN) { const int l = r >> 12, q = r & 4095, kb = q >> 8, nb = q & 255, n0 = 32 * nb, sh = n0 < 1536 ? 0 : (n0 < 4608 ? 8 : 16);
            transpose_item(P_w_in + (size_t)l * 1024 * IN_COLS + n0 + sh, IN_COLS, W_WIN + ((size_t)l * 8192 + n0) * 1024, 1024, 64 * kb, scr, lane); continue; }
        r -= N_WIN;
        if (r < N_BR) { const int idx = r >> 8, q = r & 255, kb = q >> 5, nb = q & 31;
            transpose_item(P_w_branch + (size_t)idx * 512 * 1024 + 32 * nb, 1024, W_WBR + ((size_t)idx * 1024 + 32 * nb) * 512, 512, 64 * kb, scr, lane); continue; }
        r -= N_BR;
        if (r < N_OUT) { const int l = r >> 9, q = r & 511, kb = q >> 5, nb = q & 31;
            transpose_item(P_w_out + (size_t)l * 1024 * 1024 + 32 * nb, 1024, W_WOUT + ((size_t)l * 1024 + 32 * nb) * 1024, 1024, 64 * kb, scr, lane); continue; }
        r -= N_OUT;
        if (r < N_GU) { const int idx = r >> 8, le = idx >> 1, up = idx & 1, q = r & 255, kb = q >> 4, nb = q & 15, n0 = 32 * nb, drow = (n0 >> 7) * 256 + (n0 & 127) + up * 128;
            transpose_item((up ? P_w_up : P_w_gate) + (size_t)le * 1024 * 512 + n0, 512, W_WGU + ((size_t)le * 1024 + drow) * 1024, 1024, 64 * kb, scr, lane); continue; }
        r -= N_GU;
        { const int le = r >> 8, q = r & 255, kb = q >> 5, nb = q & 31;
            transpose_item(P_w_down + (size_t)le * 512 * 1024 + 32 * nb, 1024, W_WD + ((size_t)le * 1024 + 32 * nb) * 512, 512, 64 * kb, scr, lane); }
    }
    const int gt = F.vcu * 512 + F.tid, NGT = F.G * 512;
    for (int i = gt; i < NL * 16 * 1024; i += NGT) { const int l = i >> 14, j = (i >> 10) & 15, k = i & 1023; const int oc = j < 8 ? 1536 + j : 4616 + (j - 8);
        W_WSM[i] = P_w_in[((size_t)l * 1024 + k) * IN_COLS + oc]; }
    for (int i = gt; i < NL * 36 * 1024; i += NGT) { const int l = i / 36864, q = i % 36864, j = q >> 10, k = q & 1023;
        W_WRT[i] = j < 4 ? P_w_group[((size_t)l * 1024 + k) * 4 + j] : P_w_router[((size_t)l * 1024 + k) * 32 + (j - 4)]; }
}

__device__ __forceinline__ int build_tile_table(Frame& F, int l, LAS int* tab) {
    __syncthreads();
    if (F.tid < 64) {
        const unsigned cnt = F.tid < 32 ? __hip_atomic_load(F.ctl + CW_CNT + (l * 32 + (F.tid & 31)) * 64, __ATOMIC_RELAXED, __HIP_MEMORY_SCOPE_AGENT) : 0u;
        int nt = (int)((cnt + 255u) >> 8), inc = nt;
#pragma unroll
        for (int o = 1; o < 32; o <<= 1) { const int v = __shfl_up(inc, o); if (F.lane >= o) inc += v; }
        if (F.tid < 32) { tab[F.tid] = inc - nt; tab[64 + F.tid] = (int)cnt; }
        if (F.tid == 31) tab[32] = inc; }
    __syncthreads();
    return tab[32];
}

#define TR_STEP(HALF, OFF) { const bool hi_ = (lane & (OFF)) != 0; _Pragma("unroll") for (int i_ = 0; i_ < (HALF); ++i_) { \
        const float snd_ = hi_ ? v[i_] : v[(HALF) + i_]; const float kp_ = hi_ ? v[(HALF) + i_] : v[i_]; v[i_] = kp_ + __shfl_xor(snd_, (OFF)); } }
__device__ __forceinline__ float treduce16(float (&v)[16], int lane) { TR_STEP(8, 32) TR_STEP(4, 16) TR_STEP(2, 8) TR_STEP(1, 4) float r = v[0]; r += __shfl_xor(r, 2); r += __shfl_xor(r, 1); return r; }
__device__ __forceinline__ float treduce32(float (&v)[32], int lane) { TR_STEP(16, 32) TR_STEP(8, 16) TR_STEP(4, 8) TR_STEP(2, 4) TR_STEP(1, 2) float r = v[0]; r += __shfl_xor(r, 1); return r; }
__device__ __forceinline__ float treduce4(float (&v)[4], int lane) { TR_STEP(2, 32) TR_STEP(1, 16) float r = v[0]; r += __shfl_xor(r, 8); r += __shfl_xor(r, 4); r += __shfl_xor(r, 2); r += __shfl_xor(r, 1); return r; }
#undef TR_STEP
constexpr int GRPW_OFF = 131072;
template <bool FFN>
__device__ __forceinline__ void phase_norm(Frame& F, int l) {
    const int lane = F.lane, gw = F.vcu * NWAVES + F.wave, NGW = F.G * NWAVES;
    const bool comb = (!FFN) && l > 0;
    LAS float* WL = (LAS float*)F.lds; LAS float* WG = (LAS float*)(F.lds + GRPW_OFF);
    if (!FFN) { const f32x4* s = (const f32x4*)(W_WSM + (size_t)l * 16 * 1024); for (int i = F.tid; i < 4096; i += 512) ((LAS f32x4*)WL)[i] = s[i]; }
    else { const f32x4* s = (const f32x4*)(W_WRT + (size_t)l * 36 * 1024); for (int i = F.tid; i < 8192; i += 512) ((LAS f32x4*)WL)[i] = s[1024 + i];
           for (int i = F.tid; i < 1024; i += 512) ((LAS f32x4*)WG)[i] = s[i]; }
    f32x4 A4[4], B4[4], G4[4];
    const float* ng = (FFN ? P_norm_ffn : P_norm_mix) + l * 1024;
#pragma unroll
    for (int j = 0; j < 4; ++j) { const int col = j * 256 + 4 * lane; const f32x4 g = *(const f32x4*)(ng + col);
        f32x4 sh, sc;
        if (!FFN && l == 0) { sh = modv4<false>(F, l, 0, col); sc = modv4<false>(F, l, 1, col); }
        else { sh = modv4<true>(F, l, FFN ? 3 : 0, col); sc = modv4<true>(F, l, FFN ? 4 : 1, col); }
        A4[j] = g * (sc + 1.0f); B4[j] = sh; G4[j] = comb ? modv4<true>(F, l - 1, 5, col) : (f32x4){0.f, 0.f, 0.f, 0.f}; }
    const float* xin = (!FFN && l == 0) ? P_x : F.out;
    LAS int* ttab = (LAS int*)(F.lds + MISC_OFF + 3072);
    if (comb) build_tile_table(F, l - 1, ttab);
    float be = 0.f, bg = 0.f;
    LAS int* lcnt = (LAS int*)(F.lds + MISC_OFF + 2048); LAS int* lbase = lcnt + 32;
    if (FFN) { be = P_b_router[l * 32 + ((lane >> 1) & 31)]; bg = P_b_group[l * 4 + ((lane >> 4) & 3)]; if (F.tid < 32) lcnt[F.tid] = 0; }
    __syncthreads();
    for (int m0 = 2 * gw; m0 < SEQ; m0 += 2 * NGW) {
        f32x4 v[2][4];
#pragma unroll
        for (int r = 0; r < 2; ++r)
#pragma unroll
            for (int j = 0; j < 4; ++j) v[r][j] = ((const f32x4*)(xin + (size_t)(m0 + r) * 1024))[64 * j + lane];
        if (comb) {
#pragma unroll
            for (int r = 0; r < 2; ++r) { const int m = m0 + r;
                const int s0 = ttab[W_PAIRE[2 * m]] * 256 + W_PAIRS[2 * m], s1 = ttab[W_PAIRE[2 * m + 1]] * 256 + W_PAIRS[2 * m + 1]; const float w0 = W_PAIRW[2 * m], w1 = W_PAIRW[2 * m + 1];
                const v2u* y0 = (const v2u*)(W_YP + (size_t)s0 * 1024); const v2u* y1 = (const v2u*)(W_YP + (size_t)s1 * 1024);
#pragma unroll
                for (int j = 0; j < 4; ++j) { const v2u a = y0[64 * j + lane], b = y1[64 * j + lane];
                    f32x4 y; y[0] = w0 * bflo(a.x) + w1 * bflo(b.x); y[1] = w0 * bfhi(a.x) + w1 * bfhi(b.x); y[2] = w0 * bflo(a.y) + w1 * bflo(b.y); y[3] = w0 * bfhi(a.y) + w1 * bfhi(b.y);
                    v[r][j] += G4[j] * y; ((f32x4*)(F.out + (size_t)m * 1024))[64 * j + lane] = v[r][j]; } }
        }
        float ss[2];
#pragma unroll
        for (int r = 0; r < 2; ++r) { float s = 0.f;
#pragma unroll
            for (int j = 0; j < 4; ++j) s += (v[r][j][0] * v[r][j][0] + v[r][j][1] * v[r][j][1]) + (v[r][j][2] * v[r][j][2] + v[r][j][3] * v[r][j][3]);
            ss[r] = s; }
#pragma unroll
        for (int o = 1; o < 64; o <<= 1) { ss[0] += __shfl_xor(ss[0], o); ss[1] += __shfl_xor(ss[1], o); }
#pragma unroll
        for (int r = 0; r < 2; ++r) { const float rstd = rsqrtf(ss[r] * (1.0f / 1024.0f) + EPS);
#pragma unroll
            for (int j = 0; j < 4; ++j) { v[r][j] = v[r][j] * rstd * A4[j] + B4[j];
                v2u o; o.x = pk2(v[r][j][0], v[r][j][1]); o.y = pk2(v[r][j][2], v[r][j][3]); ((v2u*)(W_HB + (size_t)(m0 + r) * 1024))[64 * j + lane] = o; } }
        if (!FFN) {
            float a0[16], a1[16]; const LAS float* wl = WL + 4 * lane; asm volatile("" : "+v"(wl));
#pragma unroll
            for (int c = 0; c < 16; ++c) { f32x2 q0 = (f32x2){0.f, 0.f}, q1 = (f32x2){0.f, 0.f};
#pragma unroll
                for (int j = 0; j < 4; ++j) { const f32x4 w = *(const LAS f32x4*)(wl + c * 1024 + j * 256);
                    const f32x2 wa = (f32x2){w[0], w[1]}, wb = (f32x2){w[2], w[3]};
                    q0 += (f32x2){v[0][j][0], v[0][j][1]} * wa; q0 += (f32x2){v[0][j][2], v[0][j][3]} * wb; q1 += (f32x2){v[1][j][0], v[1][j][1]} * wa; q1 += (f32x2){v[1][j][2], v[1][j][3]} * wb; }
                a0[c] = q0.x + q0.y; a1[c] = q1.x + q1.y; if ((c & 7) == 7) asm volatile("" ::: "memory"); }
            const float r0 = treduce16(a0, lane), r1 = treduce16(a1, lane);
            if ((lane & 3) == 0) { W_SMALL[(size_t)m0 * 16 + (lane >> 2)] = r0; W_SMALL[(size_t)(m0 + 1) * 16 + (lane >> 2)] = r1; }
        } else {
            float e0[32], e1[32], g0[4], g1[4];
            const LAS float* wlo = WL + 4 * lane; const LAS float* whi = WL + 16384 + 4 * lane; const LAS float* wgl = WG + 4 * lane; asm volatile("" : "+v"(wlo), "+v"(whi), "+v"(wgl));
#pragma unroll
            for (int c = 0; c < 32; ++c) { f32x2 q0 = (f32x2){0.f, 0.f}, q1 = (f32x2){0.f, 0.f};
#pragma unroll
                for (int j = 0; j < 4; ++j) { const f32x4 w = *(const LAS f32x4*)((c < 16 ? wlo : whi) + (c & 15) * 1024 + j * 256);
                    const f32x2 wa = (f32x2){w[0], w[1]}, wb = (f32x2){w[2], w[3]};
                    q0 += (f32x2){v[0][j][0], v[0][j][1]} * wa; q0 += (f32x2){v[0][j][2], v[0][j][3]} * wb; q1 += (f32x2){v[1][j][0], v[1][j][1]} * wa; q1 += (f32x2){v[1][j][2], v[1][j][3]} * wb; }
                e0[c] = q0.x + q0.y; e1[c] = q1.x + q1.y; if ((c & 7) == 7) asm volatile("" ::: "memory"); }
#pragma unroll
            for (int c = 0; c < 4; ++c) { f32x2 q0 = (f32x2){0.f, 0.f}, q1 = (f32x2){0.f, 0.f};
#pragma unroll
                for (int j = 0; j < 4; ++j) { const f32x4 w = *(const LAS f32x4*)(wgl + c * 1024 + j * 256);
                    const f32x2 wa = (f32x2){w[0], w[1]}, wb = (f32x2){w[2], w[3]};
                    q0 += (f32x2){v[0][j][0], v[0][j][1]} * wa; q0 += (f32x2){v[0][j][2], v[0][j][3]} * wb; q1 += (f32x2){v[1][j][0], v[1][j][1]} * wa; q1 += (f32x2){v[1][j][2], v[1][j][3]} * wb; }
                g0[c] = q0.x + q0.y; g1[c] = q1.x + q1.y; }
            float xe[2], xg[2];
            xe[0] = treduce32(e0, lane) + be; xe[1] = treduce32(e1, lane) + be; xg[0] = treduce4(g0, lane) + bg; xg[1] = treduce4(g1, lane) + bg;
#pragma unroll
            for (int r = 0; r < 2; ++r) { const int m = m0 + r;
                float lgr[4];
#pragma unroll
                for (int c = 0; c < 4; ++c) lgr[c] = __shfl(xg[r], c << 4);
                int gs = 0; float gm = lgr[0];
#pragma unroll
                for (int c = 1; c < 4; ++c) if (lgr[c] > gm) { gm = lgr[c]; gs = c; }
                float den = 0.f;
#pragma unroll
                for (int c = 0; c < 4; ++c) den += __expf(lgr[c] - gm);
                const float pg = 1.0f / den;
                float lr[8];
#pragma unroll
                for (int i = 0; i < 8; ++i) lr[i] = __shfl(xe[r], (8 * gs + i) << 1);
                int i1 = 0; float m1 = lr[0];
#pragma unroll
                for (int i = 1; i < 8; ++i) if (lr[i] > m1) { m1 = lr[i]; i1 = i; }
                int i2 = -1; float m2 = -3.0e38f;
#pragma unroll
                for (int i = 0; i < 8; ++i) if (i != i1 && lr[i] > m2) { m2 = lr[i]; i2 = i; }
                const float t = __expf(m2 - m1), w1 = pg / (1.0f + t), w2 = pg * t / (1.0f + t);
                if (lane == 0) {
                    const int e1i = gs * 8 + i1, e2i = gs * 8 + i2;
                    const int p1 = __hip_atomic_fetch_add(lcnt + e1i, 1, __ATOMIC_RELAXED, __HIP_MEMORY_SCOPE_WORKGROUP), p2 = __hip_atomic_fetch_add(lcnt + e2i, 1, __ATOMIC_RELAXED, __HIP_MEMORY_SCOPE_WORKGROUP);
                    W_PAIRE[2 * m] = e1i; W_PAIRE[2 * m + 1] = e2i; W_PAIRS[2 * m] = (int)p1; W_PAIRS[2 * m + 1] = (int)p2; W_PAIRW[2 * m] = w1; W_PAIRW[2 * m + 1] = w2;
                } }
        }
    }
    if (FFN) {
        asm volatile("s_waitcnt vmcnt(0)" ::: "memory");
        __syncthreads();
        if (F.tid < 32) { const int c = lcnt[F.tid]; lbase[F.tid] = c ? (int)atomicAdd(F.ctl + CW_CNT + (l * 32 + F.tid) * 64, (unsigned)c) : 0; }
        __syncthreads();
        for (int m0 = 2 * gw; m0 < SEQ; m0 += 2 * NGW) if (lane < 4) { const int idx = 2 * m0 + lane, e = W_PAIRE[idx], pos = W_PAIRS[idx] + lbase[e];
            W_PAIRS[idx] = pos; W_TOKOF[e * 16384 + pos] = m0 + (lane >> 1); }
    }
    if (!FFN && l == 0) {
        for (int i = F.vcu * 512 + F.tid; i < NL * 6144; i += F.G * 512) { float a = P_b_ada[i];
#pragma unroll
            for (int k = 0; k < 8; ++k) a += W_MODP[(size_t)k * 24576 + i];
            W_MODF[i] = a; }
    }
    __syncthreads();
}


typedef short bf16x8 __attribute__((ext_vector_type(8)));
#define MFMA16(a, b, c) __builtin_amdgcn_mfma_f32_16x16x32_bf16(a, b, c, 0, 0, 0)
constexpr int GX_KN = 0, GX_QN = 17408, GX_LM = 34816, GX_MX = 62464, GX_TRT = 79872, GX_SC = 116736;

__device__ __forceinline__ void gdn_phase_x(Frame& F, int l) {
    LAS unsigned char* L = F.lds;
    LAS bf16* Kn = (LAS bf16*)(L + GX_KN);
    LAS bf16* Qn = (LAS bf16*)(L + GX_QN);
    LAS bf16* LM = (LAS bf16*)(L + GX_LM);
    LAS float* Mx = (LAS float*)(L + GX_MX);
    LAS bf16* TRT = (LAS bf16*)(L + GX_TRT);
    const int tid = F.tid, lane = F.lane, w = F.wave, r16 = lane & 15, kq = lane >> 4;
    const float* cw = P_gdn_conv_w + (size_t)l * 4 * 1536;
    LAS float* SC = (LAS float*)(L + GX_SC);
    for (int k = w; F.vcu + k * F.G < 1024; k += NWAVES) { const int u = F.vcu + k * F.G, hh = u >> 8, t0 = (u & 255) * 64; LAS float* s = SC + k * 320;
        float g = -__expf(P_gdn_a_log[l * 4 + hh]) * softplus_f(W_SMALL[(size_t)(t0 + lane) * 16 + 8 + hh] + P_gdn_dt_bias[l * 4 + hh]);
#pragma unroll
        for (int o = 1; o < 64; o <<= 1) { const float v = __shfl_up(g, o); if (lane >= o) g += v; }
        const float gl = __shfl(g, 63), b = sigmoid_f(W_SMALL[(size_t)(t0 + lane) * 16 + 12 + hh]), ga = __expf(g);
        s[lane] = g; s[64 + lane] = b; s[128 + lane] = ga; s[192 + lane] = __expf(gl - g); s[256 + lane] = b * ga;
        if (lane == 63) W_GDEC[u] = ga; }
    v4u xr[3][4][2];
#define GX_LOADX(uu, S0, S1) do { const int hh_ = (uu) >> 8, t0_ = ((uu) & 255) * 64, t_ = tid >> 3, c8_ = tid & 7; _Pragma("unroll") for (int sg_ = (S0); sg_ < (S1); ++sg_) _Pragma("unroll") for (int i_ = 0; i_ < 4; ++i_) { \
        const int ts_ = t0_ + t_ - 3 + i_; const bf16* xp_ = W_PROJ + (size_t)(ts_ < 0 ? 0 : ts_) * NPROJ + C_GQKV + sg_ * 512 + hh_ * 128 + 16 * c8_; xr[sg_][i_][0] = *(const v4u*)xp_; xr[sg_][i_][1] = *(const v4u*)(xp_ + 8); } } while (0)
    if (F.vcu < 1024) GX_LOADX(F.vcu, 0, 2);
    __syncthreads();
    int kun = 0;
    const int tid_outer = tid;
    for (int u = F.vcu; u < 1024; u += F.G, ++kun) {
        int tid_l = tid_outer; asm volatile("" : "+v"(tid_l));
        const int tid = tid_l, lane = tid & 63, r16 = lane & 15, kq = lane >> 4;
        const int hh = u >> 8, ch = u & 255, t0 = ch * 64;
        LAS float* gc = SC + kun * 320; LAS float* be = gc + 64; LAS float* gam = be + 64; LAS float* kdec = gam + 64; LAS float* bg = kdec + 64;
        { const int t = tid >> 3, c8 = tid & 7;
          GX_LOADX(u, 2, 3);
#pragma unroll
          for (int sg = 0; sg < 3; ++sg) { const int cb = sg * 512 + hh * 128 + 16 * c8; float a[16];
#pragma unroll
            for (int e = 0; e < 16; ++e) a[e] = 0.f;
#pragma unroll
            for (int i = 0; i < 4; ++i) { const int ts = t0 + t - 3 + i; const float msk = ts < 0 ? 0.f : 1.f; float xv[16]; unpack8(xr[sg][i][0], xv); unpack8(xr[sg][i][1], xv + 8);
#pragma unroll
                for (int e4 = 0; e4 < 4; ++e4) { const f32x4 wv = *(const f32x4*)(cw + i * 1536 + cb + 4 * e4) * msk;
                    a[4 * e4] += wv[0] * xv[4 * e4]; a[4 * e4 + 1] += wv[1] * xv[4 * e4 + 1]; a[4 * e4 + 2] += wv[2] * xv[4 * e4 + 2]; a[4 * e4 + 3] += wv[3] * xv[4 * e4 + 3]; } }
            float ss = 0.f;
#pragma unroll
            for (int e = 0; e < 16; ++e) { a[e] = silu_f(a[e]); ss += a[e] * a[e]; }
            if (sg < 2) { ss += __shfl_xor(ss, 1); ss += __shfl_xor(ss, 2); ss += __shfl_xor(ss, 4); const float sc = rsqrtf(ss + EPS) * (sg == 0 ? 0.08838834764831845f : 1.0f);
#pragma unroll
                for (int e = 0; e < 16; ++e) a[e] *= sc; }
            if (sg == 0) { v4u o0, o1; o0.x = pk2(a[0], a[1]); o0.y = pk2(a[2], a[3]); o0.z = pk2(a[4], a[5]); o0.w = pk2(a[6], a[7]); o1.x = pk2(a[8], a[9]); o1.y = pk2(a[10], a[11]); o1.z = pk2(a[12], a[13]); o1.w = pk2(a[14], a[15]);
                *(LAS v4u*)(Qn + t * 136 + 16 * c8) = o0; *(LAS v4u*)(Qn + t * 136 + 16 * c8 + 8) = o1; }
            else if (sg == 1) { v4u o0, o1; o0.x = pk2(a[0], a[1]); o0.y = pk2(a[2], a[3]); o0.z = pk2(a[4], a[5]); o0.w = pk2(a[6], a[7]); o1.x = pk2(a[8], a[9]); o1.y = pk2(a[10], a[11]); o1.z = pk2(a[12], a[13]); o1.w = pk2(a[14], a[15]);
                *(LAS v4u*)(Kn + t * 136 + 16 * c8) = o0; *(LAS v4u*)(Kn + t * 136 + 16 * c8 + 8) = o1;
                const float kd = kdec[t], bgt = bg[t];
#pragma unroll
                for (int e = 0; e < 16; ++e) { LM[(16 * c8 + e) * 72 + t] = (bf16)f2bf(a[e] * kd); TRT[(16 * c8 + e) * 72 + t] = (bf16)f2bf(a[e] * bgt); } }
            else { const float bt = be[t];
#pragma unroll
                for (int e = 0; e < 16; ++e) TRT[(128 + 16 * c8 + e) * 72 + t] = (bf16)f2bf(a[e] * bt); }
            asm volatile("" ::: "memory"); } }
        __syncthreads();
        { const LAS bf16* Ab = (w < 4 ? Kn : Qn) + (16 * (w & 3) + r16) * 136 + 8 * kq; bf16x8 a[4];
#pragma unroll
          for (int ks = 0; ks < 4; ++ks) a[ks] = *(const LAS bf16x8*)(Ab + 32 * ks);
#pragma unroll
          for (int nt = 0; nt < 4; ++nt) { f32x4 d = (f32x4){0.f, 0.f, 0.f, 0.f};
#pragma unroll
            for (int ks = 0; ks < 4; ++ks) { const bf16x8 b = *(const LAS bf16x8*)(Kn + (16 * nt + r16) * 136 + 32 * ks + 8 * kq); d = MFMA16(a[ks], b, d); }
            const int jt = 16 * nt + r16; const float gj = gc[jt];
#pragma unroll
            for (int j = 0; j < 4; ++j) { const int i = 16 * (w & 3) + 4 * kq + j; const float e = __expf(gc[i] - gj);
                if (w < 4) Mx[jt * 68 + i] = (jt < i) ? be[i] * d[j] * e : 0.f;
                else LM[(128 + i) * 72 + jt] = (bf16)f2bf((jt <= i) ? d[j] * e : 0.f); } } }
        __syncthreads();
        if (u + F.G < 1024) GX_LOADX(u + F.G, 0, 2);
        if (w < 4) { LAS bf16* row = TRT + (64 * w + lane) * 72;
            const LAS float* Mto = Mx; asm volatile("" : "+v"(Mto));
#pragma unroll 1
            for (int rb = 0; rb < 4; ++rb) {
                float acc[16];
                unpack8(*(const LAS v4u*)(row + 16 * rb), acc); unpack8(*(const LAS v4u*)(row + 16 * rb + 8), acc + 8);
#pragma unroll 1
                for (int j8 = 0; j8 < 2 * rb; ++j8) {
                    float xv[8]; unpack8(*(const LAS v4u*)(row + 8 * j8), xv);
#pragma unroll
                    for (int e = 0; e < 8; ++e) { const LAS float* mp = Mto + (8 * j8 + e) * 68 + 16 * rb;
#pragma unroll
                        for (int q = 0; q < 4; ++q) { const f32x4 m = *(const LAS f32x4*)(mp + 4 * q);
#pragma unroll
                            for (int k = 0; k < 4; ++k) acc[4 * q + k] -= m[k] * xv[e]; }
                        if (e & 1) asm volatile("" ::: "memory"); } }
#pragma unroll
                for (int jj = 0; jj < 15; ++jj) { const LAS float* mp = Mto + (16 * rb + jj) * 68 + 16 * rb;
#pragma unroll
                    for (int q = (jj + 1) / 4; q < 4; ++q) { const f32x4 m = *(const LAS f32x4*)(mp + 4 * q);
#pragma unroll
                        for (int k = 0; k < 4; ++k) if (4 * q + k > jj) acc[4 * q + k] -= m[k] * acc[jj]; }
                    if (jj & 1) asm volatile("" ::: "memory"); }
                v4u o0, o1; o0.x = pk2(acc[0], acc[1]); o0.y = pk2(acc[2], acc[3]); o0.z = pk2(acc[4], acc[5]); o0.w = pk2(acc[6], acc[7]);
                o1.x = pk2(acc[8], acc[9]); o1.y = pk2(acc[10], acc[11]); o1.z = pk2(acc[12], acc[13]); o1.w = pk2(acc[14], acc[15]);
                *(LAS v4u*)(row + 16 * rb) = o0; *(LAS v4u*)(row + 16 * rb + 8) = o1; } }
        __syncthreads();
        { bf16x8 bfr[2][2];
#pragma unroll
          for (int n2 = 0; n2 < 2; ++n2)
#pragma unroll
            for (int ks = 0; ks < 2; ++ks) bfr[n2][ks] = *(const LAS bf16x8*)(TRT + (16 * (2 * w + n2) + r16) * 72 + 32 * ks + 8 * kq);
          bf16* AP = W_GAP + (size_t)u * 16384; bf16* BT = W_GBT + (size_t)u * 16384; bf16* QE = W_GQE + (size_t)u * 8192; bf16* OU = W_GOU + (size_t)u * 8192;
#pragma unroll 1
          for (int mt = 0; mt < 8; ++mt) { bf16x8 af[2];
#pragma unroll
            for (int ks = 0; ks < 2; ++ks) af[ks] = *(const LAS bf16x8*)(LM + (16 * mt + r16) * 72 + 32 * ks + 8 * kq);
#pragma unroll
            for (int n2 = 0; n2 < 2; ++n2) { const int nt = 2 * w + n2; f32x4 d = (f32x4){0.f, 0.f, 0.f, 0.f};
                if (w >= 4) {
#pragma unroll
                    for (int ks = 0; ks < 2; ++ks) d = MFMA16(af[ks], bfr[n2][ks], d);
                    v2u o; o.x = pk2(d[0], d[1]); o.y = pk2(d[2], d[3]);
                    *(v2u*)(BT + (((nt - 8) * 4 + (mt >> 1)) * 64 + lane) * 8 + 4 * (mt & 1)) = o;
                } else {
#pragma unroll
                    for (int ks = 0; ks < 2; ++ks) d = MFMA16(bfr[n2][ks], af[ks], d);
                    v2u o; o.x = pk2(-d[0], -d[1]); o.y = pk2(-d[2], -d[3]);
                    *(v2u*)(AP + (((mt * 4 + (nt >> 1)) * 64 + kq * 16 + r16) * 8 + 4 * (nt & 1))) = o; } } }
#pragma unroll 1
          for (int mt = 8; mt < 12; ++mt) { bf16x8 af[2];
#pragma unroll
            for (int ks = 0; ks < 2; ++ks) af[ks] = *(const LAS bf16x8*)(LM + (16 * mt + r16) * 72 + 32 * ks + 8 * kq);
            const int i = 16 * (mt - 8) + r16;
#pragma unroll
            for (int n2 = 0; n2 < 2; ++n2) { const int nt = 2 * w + n2; f32x4 d = (f32x4){0.f, 0.f, 0.f, 0.f};
#pragma unroll
                for (int ks = 0; ks < 2; ++ks) d = MFMA16(bfr[n2][ks], af[ks], d);
                if (w < 4) { const int dkc = 16 * nt + 4 * kq; const v2u qv = *(const LAS v2u*)(Qn + i * 136 + dkc); const float gi = gam[i];
                    v2u o; o.x = pk2(gi * bflo(qv.x) - d[0], gi * bfhi(qv.x) - d[1]); o.y = pk2(gi * bflo(qv.y) - d[2], gi * bfhi(qv.y) - d[3]);
                    *(v2u*)(QE + i * 128 + dkc) = o; }
                else { const int dv = 16 * (nt - 8) + 4 * kq; v2u o; o.x = pk2(d[0], d[1]); o.y = pk2(d[2], d[3]);
                    *(v2u*)(OU + i * 128 + dv) = o; } } } }
        __syncthreads();
    }
}

template <int LEVEL>
__device__ __forceinline__ void gdn_seg(Frame& F, int hh, int sc, int half) {
    LAS unsigned char* L = F.lds; const int tid = F.tid, lane = F.lane, w = F.wave, r16 = lane & 15, kq = lane >> 4;
    LAS float* decs = (LAS float*)(L + MISC_OFF + 1024);
    const bool compute = (LEVEL == 1) || (w < 4), storing = (LEVEL != 1) && (w < 4), hasB = (LEVEL == 1) ? (w >= 4) : (w < 4);
    const size_t u0 = LEVEL == 2 ? (size_t)hh * 16 : (size_t)hh * 256 + 16 * sc;
    const bf16* AP = (LEVEL == 2 ? W_GAP2 : W_GAP) + u0 * 16384;
    const bf16* BT = (LEVEL == 2 ? W_GBT2 : W_GBT) + u0 * 16384 + half * 8192;
    const int lt = w & 3, nt = 4 * half + lt;
    if (LEVEL != 2 && tid < 16) decs[tid] = W_GDEC[hh * 256 + 16 * sc + tid];
    f32x4 acc[8];
#pragma unroll
    for (int t = 0; t < 8; ++t) acc[t] = (f32x4){0.f, 0.f, 0.f, 0.f};
    if (LEVEL == 1 && w < 4) {
#pragma unroll
        for (int t = 0; t < 8; ++t)
#pragma unroll
            for (int j = 0; j < 4; ++j) acc[t][j] = (16 * t + 4 * kq + j == 16 * nt + r16) ? 1.0f : 0.0f; }
    if (LEVEL == 3 && compute) { const bf16* S0 = W_GST2 + ((size_t)hh * 16 + sc) * 16384 + (size_t)(16 * nt + r16) * 128 + 4 * kq;
#pragma unroll
        for (int t = 0; t < 8; ++t) { const v2u v = *(const v2u*)(S0 + 16 * t); acc[t] = (f32x4){bflo(v.x), bfhi(v.x), bflo(v.y), bfhi(v.y)}; } }
#define GS_DMA(c) do { const int c_ = (c) < 15 ? (c) : 15; LAS unsigned char* s_ = L + ((c) % 3) * 49152; _Pragma("unroll") for (int i_ = 0; i_ < 4; ++i_) \
        __builtin_amdgcn_global_load_lds((const unsigned*)(AP + (size_t)c_ * 16384 + (i_ * 8 + w) * 512 + lane * 8), (LAS unsigned*)(s_ + (i_ * 8 + w) * 1024), 16, 0, 0); \
        _Pragma("unroll") for (int i_ = 0; i_ < 2; ++i_) \
        __builtin_amdgcn_global_load_lds((const unsigned*)(BT + (size_t)c_ * 16384 + (i_ * 8 + w) * 512 + lane * 8), (LAS unsigned*)(s_ + 32768 + (i_ * 8 + w) * 1024), 16, 0, 0); } while (0)
    asm volatile("s_waitcnt vmcnt(0)" ::: "memory");
    GS_DMA(0); GS_DMA(1);
    __syncthreads();
#pragma unroll 1
    for (int i = 0; i < 16; ++i) {
        if (storing && i > 0) asm volatile("s_waitcnt vmcnt(14)" ::: "memory"); else asm volatile("s_waitcnt vmcnt(6)" ::: "memory");
        __builtin_amdgcn_s_barrier(); asm volatile("" ::: "memory");
        GS_DMA(i + 2);
        if (compute) {
            bf16x8 Sb[4]; unsigned pk_[8][2];
#pragma unroll
            for (int t = 0; t < 8; ++t) { pk_[t][0] = pg8::cvt_pk_bf16(acc[t][0], acc[t][1]); pk_[t][1] = pg8::cvt_pk_bf16(acc[t][2], acc[t][3]); }
            if (LEVEL != 1) { bf16* ST = (LEVEL == 2 ? W_GST2 + ((size_t)hh * 16 + i) * 16384 : W_GST + ((size_t)hh * 256 + 16 * sc + i) * 16384) + (size_t)(16 * nt + r16) * 128 + 4 * kq;
#pragma unroll
                for (int t = 0; t < 8; ++t) { v2u o_; o_.x = pk_[t][0]; o_.y = pk_[t][1]; *(v2u*)(ST + 16 * t) = o_; } }
#pragma unroll
            for (int s = 0; s < 4; ++s) { v4u q_; q_.x = pk_[2 * s][0]; q_.y = pk_[2 * s][1]; q_.z = pk_[2 * s + 1][0]; q_.w = pk_[2 * s + 1][1]; Sb[s] = __builtin_bit_cast(bf16x8, q_); }
            const float dc = LEVEL == 2 ? 0.f : decs[i];
#pragma unroll
            for (int t = 0; t < 8; ++t) acc[t] = acc[t] * dc;
            const LAS unsigned char* slot = L + (i % 3) * 49152 + lane * 16;
#pragma unroll
            for (int s = 0; s < 4; ++s) { bf16x8 fa[8];
#pragma unroll
                for (int t = 0; t < 8; ++t) fa[t] = *(const LAS bf16x8*)(slot + (t * 4 + s) * 1024);
#pragma unroll
                for (int t = 0; t < 8; ++t) acc[t] = MFMA16(fa[t], Sb[s], acc[t]); }
            if (hasB) {
#pragma unroll
                for (int i4 = 0; i4 < 4; ++i4) { const v4u bv = *(const LAS v4u*)(slot + 32768 + (lt * 4 + i4) * 1024);
                    acc[2 * i4][0] += bflo(bv.x); acc[2 * i4][1] += bfhi(bv.x); acc[2 * i4][2] += bflo(bv.y); acc[2 * i4][3] += bfhi(bv.y);
                    acc[2 * i4 + 1][0] += bflo(bv.z); acc[2 * i4 + 1][1] += bfhi(bv.z); acc[2 * i4 + 1][2] += bflo(bv.w); acc[2 * i4 + 1][3] += bfhi(bv.w); } }
        }
    }
    asm volatile("s_waitcnt vmcnt(0)" ::: "memory");
    if (LEVEL == 1) {
        bf16* A2 = W_GAP2 + ((size_t)hh * 16 + sc) * 16384; bf16* B2 = W_GBT2 + ((size_t)hh * 16 + sc) * 16384;
        if (w < 4) {
#pragma unroll
            for (int t = 0; t < 8; ++t)
#pragma unroll
                for (int j = 0; j < 4; ++j) A2[((t * 4 + (nt >> 1)) * 64 + (r16 >> 2) * 16 + 4 * kq + j) * 8 + 4 * (nt & 1) + (r16 & 3)] = (bf16)f2bf(acc[t][j]);
        } else {
#pragma unroll
            for (int t = 0; t < 8; ++t) { v2u o_; o_.x = pk2(acc[t][0], acc[t][1]); o_.y = pk2(acc[t][2], acc[t][3]); *(v2u*)(B2 + ((nt * 4 + (t >> 1)) * 64 + lane) * 8 + 4 * (t & 1)) = o_; } } }
    __syncthreads();
#undef GS_DMA
}

__device__ __forceinline__ void gdn_phase_z(Frame& F, int l) {
    const int lane = F.lane, r16 = lane & 15, kq = lane >> 4, gw = F.vcu * NWAVES + F.wave, NGW = F.G * NWAVES;
    for (int wu = gw; wu < 4096; wu += NGW) { const int u = wu >> 2, mt = wu & 3, hh = u >> 8, ch = u & 255, tok = ch * 64 + 16 * mt + r16;
        const bf16* QE = W_GQE + (size_t)u * 8192 + (16 * mt + r16) * 128 + 8 * kq; const bf16* ST = W_GST + (size_t)u * 16384 + r16 * 128 + 8 * kq;
        bf16x8 qf[4];
#pragma unroll
        for (int s = 0; s < 4; ++s) qf[s] = *(const bf16x8*)(QE + 32 * s);
        bf16x8 sfr[8][4]; v2u our[8];
#pragma unroll
        for (int nt = 0; nt < 8; ++nt) {
#pragma unroll
            for (int s = 0; s < 4; ++s) sfr[nt][s] = *(const bf16x8*)(ST + nt * 16 * 128 + 32 * s);
            our[nt] = *(const v2u*)(W_GOU + (size_t)u * 8192 + (16 * mt + r16) * 128 + 16 * nt + 4 * kq); }
        f32x4 o[8]; float ss = 0.f;
#pragma unroll
        for (int nt = 0; nt < 8; ++nt) { f32x4 d = (f32x4){0.f, 0.f, 0.f, 0.f};
#pragma unroll
            for (int s = 0; s < 4; ++s) d = MFMA16(sfr[nt][s], qf[s], d);
            const v2u ou = our[nt];
            d[0] += bflo(ou.x); d[1] += bfhi(ou.x); d[2] += bflo(ou.y); d[3] += bfhi(ou.y);
            ss += (d[0] * d[0] + d[1] * d[1]) + (d[2] * d[2] + d[3] * d[3]); o[nt] = d; }
        ss += __shfl_xor(ss, 16); ss += __shfl_xor(ss, 32);
        const float rs = rsqrtf(ss * (1.0f / 128.0f) + EPS);
#pragma unroll
        for (int nt = 0; nt < 8; ++nt) { const int dv = 16 * nt + 4 * kq; const f32x4 gn = *(const f32x4*)(P_gdn_norm + l * 128 + dv);
            const v2u gt = *(const v2u*)(W_PROJ + (size_t)tok * NPROJ + C_GGATE + hh * 128 + dv);
            v2u y; y.x = pk2(o[nt][0] * rs * gn[0] * silu_f(bflo(gt.x)), o[nt][1] * rs * gn[1] * silu_f(bfhi(gt.x))); y.y = pk2(o[nt][2] * rs * gn[2] * silu_f(bflo(gt.y)), o[nt][3] * rs * gn[3] * silu_f(bfhi(gt.y)));
            *(v2u*)(W_YBR + (size_t)2 * SEQ * 512 + (size_t)tok * 512 + hh * 128 + dv) = y; }
    }
}


__device__ __forceinline__ void ssd_phase_c(Frame& F, int l) {
    LAS unsigned char* L = F.lds;
    LAS bf16* BTr = (LAS bf16*)L;
    LAS bf16* XWT = (LAS bf16*)(L + 34816);
    LAS float* acum = (LAS float*)(L + 104448); LAS float* dtv = acum + 512; LAS float* wgt = dtv + 512;
    const int tid = F.tid, lane = F.lane, w = F.wave, r16 = lane & 15, kq = lane >> 4;
    const float* cw = P_ssm_conv_w + (size_t)l * 4 * 1024; const float* cb = P_ssm_conv_b + (size_t)l * 1024;
    for (int u = F.vcu; u < 256; u += F.G) { const int c = u >> 1, g = u & 1, t0 = c * 128;
        if (w < 4) { const int h = 4 * g + w; const float bias = P_ssm_dt_bias[l * 8 + h], A = -__expf(P_ssm_a_log[l * 8 + h]);
            const float d0 = softplus_f(W_SMALL[(size_t)(t0 + 2 * lane) * 16 + h] + bias), d1 = softplus_f(W_SMALL[(size_t)(t0 + 2 * lane + 1) * 16 + h] + bias);
            const float a0 = A * d0, a1 = a0 + A * d1; float inc = a1;
#pragma unroll
            for (int o = 1; o < 64; o <<= 1) { const float v = __shfl_up(inc, o); if (lane >= o) inc += v; }
            const float ex = inc - a1, c0v = ex + a0, c1v = ex + a1, al = __shfl(inc, 63);
            acum[w * 128 + 2 * lane] = c0v; acum[w * 128 + 2 * lane + 1] = c1v; dtv[w * 128 + 2 * lane] = d0; dtv[w * 128 + 2 * lane + 1] = d1;
            wgt[w * 128 + 2 * lane] = __expf(al - c0v); wgt[w * 128 + 2 * lane + 1] = __expf(al - c1v);
            W_ACUM[(size_t)(t0 + 2 * lane) * 8 + h] = c0v; W_ACUM[(size_t)(t0 + 2 * lane + 1) * 8 + h] = c1v;
            if (lane == 63) W_SDEC[c * 8 + h] = __expf(al); }
        __syncthreads();
        { const int c16 = tid & 15, tq = tid >> 4;
#pragma unroll 1
          for (int k = 0; k < 4; ++k) { const int ch0 = (k < 2 ? g * 256 + 128 * k : (k == 2 ? 512 + g * 128 : 768 + g * 128)) + 8 * c16;
            f32x4 wv[4][2]; const f32x4 b0 = *(const f32x4*)(cb + ch0), b1 = *(const f32x4*)(cb + ch0 + 4);
#pragma unroll
            for (int i = 0; i < 4; ++i) { wv[i][0] = *(const f32x4*)(cw + i * 1024 + ch0); wv[i][1] = *(const f32x4*)(cw + i * 1024 + ch0 + 4); }
            const int hl = 2 * k + (c16 >> 3), p0 = 8 * (c16 & 7);
#pragma unroll
            for (int th = 0; th < 2; ++th) {
            v4u xra[2][4];
#pragma unroll
            for (int tp = 0; tp < 2; ++tp)
#pragma unroll
                for (int i = 0; i < 4; ++i) { const int ts = t0 + tq + 32 * (2 * th + tp) - 3 + i; xra[tp][i] = *(const v4u*)(W_PROJ + (size_t)(ts < 0 ? 0 : ts) * NPROJ + C_XBC + ch0); }
#pragma unroll
            for (int tp2 = 0; tp2 < 2; ++tp2) { const int t = tq + 32 * (2 * th + tp2); v4u xr[4];
#pragma unroll
                for (int i = 0; i < 4; ++i) xr[i] = xra[tp2][i];
                float a[8] = {b0[0], b0[1], b0[2], b0[3], b1[0], b1[1], b1[2], b1[3]};
#pragma unroll
                for (int i = 0; i < 4; ++i) { const float msk = (t0 + t - 3 + i) < 0 ? 0.f : 1.f; float xv[8]; unpack8(xr[i], xv);
#pragma unroll
                    for (int e = 0; e < 4; ++e) { a[e] += wv[i][0][e] * msk * xv[e]; a[4 + e] += wv[i][1][e] * msk * xv[4 + e]; } }
                v4u o;
#pragma unroll
                for (int e = 0; e < 8; ++e) a[e] = silu_f(a[e]);
                o.x = pk2(a[0], a[1]); o.y = pk2(a[2], a[3]); o.z = pk2(a[4], a[5]); o.w = pk2(a[6], a[7]);
                *(v4u*)(W_XBCB + (size_t)(t0 + t) * 1024 + ch0) = o;
                float ar[8]; unpack8(o, ar);
                if (k < 2) { const float sc = dtv[hl * 128 + t] * wgt[hl * 128 + t];
#pragma unroll
                    for (int e = 0; e < 8; ++e) { const int row = hl * 64 + p0 + e; XWT[row * 136 + (t ^ (((row >> 3) & 15) << 3))] = (bf16)f2bf(ar[e] * sc); } }
                else if (k == 2) {
#pragma unroll
                    for (int e = 0; e < 8; ++e) { const int row = 8 * c16 + e; BTr[row * 136 + (t ^ (((row >> 3) & 15) << 3))] = (bf16)f2bf(ar[e]); } } } asm volatile("" ::: "memory"); } } }
        __syncthreads();
        { const int hl = w >> 1, h = 4 * g + hl;
#pragma unroll 1
          for (int n4 = 0; n4 < 4; ++n4) { const int nt = 4 * (w & 1) + n4; bf16x8 af[4];
#pragma unroll
            for (int ks = 0; ks < 4; ++ks) { const int row = 16 * nt + r16; af[ks] = *(const LAS bf16x8*)(BTr + row * 136 + 8 * ((4 * ks + kq) ^ ((row >> 3) & 15))); }
#pragma unroll
            for (int pt = 0; pt < 4; ++pt) { f32x4 d = (f32x4){0.f, 0.f, 0.f, 0.f};
#pragma unroll
                for (int ks = 0; ks < 4; ++ks) { const int row = hl * 64 + 16 * pt + r16; const bf16x8 bfv = *(const LAS bf16x8*)(XWT + row * 136 + 8 * ((4 * ks + kq) ^ ((row >> 3) & 15))); d = MFMA16(af[ks], bfv, d); }
                *(f32x4*)(W_SST + (((size_t)c * 8 + h) * 64 + 16 * pt + r16) * 128 + 16 * nt + 4 * kq) = d; } } }
        __syncthreads();
    }
}
__device__ __forceinline__ void ssd_scan(Frame& F) {
    const int e4 = F.vcu * 512 + F.tid, h = e4 >> 11; f32x4 hc = (f32x4){0.f, 0.f, 0.f, 0.f};
#pragma unroll 1
    for (int cb = 0; cb < 128; cb += 16) { f32x4 s[16]; float dc[16];
#pragma unroll
        for (int k = 0; k < 16; ++k) { s[k] = *(const f32x4*)(W_SST + (size_t)(cb + k) * 65536 + 4 * e4); dc[k] = W_SDEC[(cb + k) * 8 + h]; }
#pragma unroll
        for (int k = 0; k < 16; ++k) { v2u o; o.x = pk2(hc[0], hc[1]); o.y = pk2(hc[2], hc[3]); *(v2u*)(W_SHIN + (size_t)(cb + k) * 65536 + 4 * e4) = o;
            hc = hc * dc[k] + s[k]; } }
}
__device__ __forceinline__ void ssd_phase_e(Frame& F, int l, int ufirst, int uend, int ustride) {
    LAS unsigned char* L = F.lds;
    LAS bf16* Bs = (LAS bf16*)L;
    LAS bf16* XDT = (LAS bf16*)(L + 34816);
    LAS float* acum = (LAS float*)(L + 104448);
    const int tid = F.tid, lane = F.lane, w = F.wave, r16 = lane & 15, kq = lane >> 4;
    for (int u = ufirst; u < uend; u += ustride) { const int c = u >> 1, g = u & 1, t0 = c * 128;
        LAS float* dts = acum + 512;
        { const int t = tid & 127, hl = tid >> 7, h = 4 * g + hl;
          acum[hl * 128 + t] = W_ACUM[(size_t)(t0 + t) * 8 + h]; dts[hl * 128 + t] = softplus_f(W_SMALL[(size_t)(t0 + t) * 16 + h] + P_ssm_dt_bias[l * 8 + h]); }
        { const int c16 = tid & 15, tq = tid >> 4;
#pragma unroll
          for (int tp = 0; tp < 4; ++tp) { const int t = tq + 32 * tp; *(LAS v4u*)(Bs + t * 136 + 8 * c16) = *(const v4u*)(W_XBCB + (size_t)(t0 + t) * 1024 + 512 + g * 128 + 8 * c16); } }
        __syncthreads();
        { const int c32 = tid & 31, tq = tid >> 5, hl = c32 >> 3, p0 = 8 * (c32 & 7);
#pragma unroll 2
          for (int tp = 0; tp < 8; ++tp) { const int t = tq + 16 * tp; float xv[8]; unpack8(*(const v4u*)(W_XBCB + (size_t)(t0 + t) * 1024 + g * 256 + 8 * c32), xv);
              const float dt = dts[hl * 128 + t];
              const int tpm = (t & ~31) + 8 * ((t >> 2) & 3) + 4 * ((t >> 4) & 1) + (t & 3);
#pragma unroll
              for (int e = 0; e < 8; ++e) { const int row = hl * 64 + p0 + e; XDT[row * 136 + (tpm ^ (((row >> 3) & 15) << 3))] = (bf16)f2bf(xv[e] * dt); } } }
        __syncthreads();
        { const int tl = 16 * w + r16, tok = t0 + tl;
          bf16x8 cf[4];
#pragma unroll
          for (int ks = 0; ks < 4; ++ks) cf[ks] = *(const bf16x8*)(W_XBCB + (size_t)tok * 1024 + 768 + g * 128 + 32 * ks + 8 * kq);
          f32x4 gt[8];
#pragma unroll
          for (int st = 0; st < 8; ++st) { f32x4 d = (f32x4){0.f, 0.f, 0.f, 0.f};
              if (st <= w) {
#pragma unroll
                  for (int ks = 0; ks < 4; ++ks) { const bf16x8 a = *(const LAS bf16x8*)(Bs + (16 * st + r16) * 136 + 32 * ks + 8 * kq); d = MFMA16(a, cf[ks], d); } }
              gt[st] = d; }
          float ss = 0.f;
#pragma unroll 1
          for (int hl = 0; hl < 4; ++hl) { const int h = 4 * g + hl; const float al = acum[hl * 128 + tl];
              f32x4 yd[4], yo[4];
#pragma unroll
              for (int pt = 0; pt < 4; ++pt) { yd[pt] = (f32x4){0.f, 0.f, 0.f, 0.f}; yo[pt] = (f32x4){0.f, 0.f, 0.f, 0.f}; }
#pragma unroll
              for (int k2 = 0; k2 < 4; ++k2) { if (2 * k2 <= w) {
                  v4u sp;
#pragma unroll
                  for (int a = 0; a < 2; ++a) { const int s0 = 32 * k2 + 16 * a + 4 * kq; const f32x4 as = *(const LAS f32x4*)(acum + hl * 128 + s0); float v[4];
#pragma unroll
                      for (int b = 0; b < 4; ++b) v[b] = (s0 + b <= tl) ? gt[2 * k2 + a][b] * __expf(al - as[b]) : 0.f;
                      if (a == 0) { sp.x = pk2(v[0], v[1]); sp.y = pk2(v[2], v[3]); } else { sp.z = pk2(v[0], v[1]); sp.w = pk2(v[2], v[3]); } }
                  const bf16x8 sf = __builtin_bit_cast(bf16x8, sp);
#pragma unroll
                  for (int pt = 0; pt < 4; ++pt) { const int row = hl * 64 + 16 * pt + r16; const bf16x8 xa = *(const LAS bf16x8*)(XDT + row * 136 + 8 * ((4 * k2 + kq) ^ ((row >> 3) & 15))); yd[pt] = MFMA16(xa, sf, yd[pt]); } } }
              const bf16* hin = W_SHIN + (((size_t)c * 8 + h) * 64 + r16) * 128 + 8 * kq;
              { bf16x8 hfr[4][4];
#pragma unroll
                for (int pt = 0; pt < 4; ++pt)
#pragma unroll
                    for (int ks = 0; ks < 4; ++ks) hfr[pt][ks] = *(const bf16x8*)(hin + pt * 16 * 128 + 32 * ks);
#pragma unroll
                for (int pt = 0; pt < 4; ++pt)
#pragma unroll
                    for (int ks = 0; ks < 4; ++ks) yo[pt] = MFMA16(hfr[pt][ks], cf[ks], yo[pt]); }
              const float eal = __expf(al), Dh = P_ssm_d[l * 8 + h];
#pragma unroll
              for (int pt = 0; pt < 4; ++pt) { const int ch = g * 256 + hl * 64 + 16 * pt + 4 * kq;
                  const v2u xr = *(const v2u*)(W_XBCB + (size_t)tok * 1024 + ch); const v2u zr = *(const v2u*)(W_PROJ + (size_t)tok * NPROJ + C_Z + ch);
                  f32x4 y = yd[pt] + eal * yo[pt]; y[0] += Dh * bflo(xr.x); y[1] += Dh * bfhi(xr.x); y[2] += Dh * bflo(xr.y); y[3] += Dh * bfhi(xr.y);
                  y[0] *= silu_f(bflo(zr.x)); y[1] *= silu_f(bfhi(zr.x)); y[2] *= silu_f(bflo(zr.y)); y[3] *= silu_f(bfhi(zr.y));
                  v2u o; o.x = pk2(y[0], y[1]); o.y = pk2(y[2], y[3]);
                  ss += (bflo(o.x) * bflo(o.x) + bfhi(o.x) * bfhi(o.x)) + (bflo(o.y) * bflo(o.y) + bfhi(o.y) * bfhi(o.y));
                  *(v2u*)(W_YBR + (size_t)tok * 512 + ch) = o; } }
          ss += __shfl_xor(ss, 16); ss += __shfl_xor(ss, 32);
          const float rs = rsqrtf(ss * (1.0f / 256.0f) + EPS);
#pragma unroll
          for (int hl = 0; hl < 4; ++hl)
#pragma unroll
              for (int pt = 0; pt < 4; ++pt) { const int ch = g * 256 + hl * 64 + 16 * pt + 4 * kq; const f32x4 gn = *(const f32x4*)(P_ssm_norm + l * 512 + ch);
                  const v2u yv = *(const v2u*)(W_YBR + (size_t)tok * 512 + ch);
                  v2u o; o.x = pk2(bflo(yv.x) * rs * gn[0], bfhi(yv.x) * rs * gn[1]); o.y = pk2(bflo(yv.y) * rs * gn[2], bfhi(yv.y) * rs * gn[3]);
                  *(v2u*)(W_YBR + (size_t)tok * 512 + ch) = o; } }
        __syncthreads();
    }
}


__device__ __forceinline__ void sb_mfma_unit(Frame& F, int l, int hh, int qb) {
    LAS bf16* Ks = (LAS bf16*)F.lds;
    LAS bf16* VT = Ks + 64 * 136;
    LAS float* red = (LAS float*)(F.lds + 35840);
    const int tid = F.tid, lane = F.lane, w = F.wave, r16 = lane & 15, kq = lane >> 4, q0 = qb * 128, tg = q0 + 16 * w + r16;
    bf16x8 qf[4];
    { const bf16* qp = W_PROJ + (size_t)tg * NPROJ + C_SBQKV + hh * 128 + 8 * kq; float qv[4][8]; float ss = 0.f;
#pragma unroll
      for (int ks = 0; ks < 4; ++ks) { unpack8(*(const v4u*)(qp + 32 * ks), qv[ks]);
#pragma unroll
          for (int e = 0; e < 8; ++e) ss += qv[ks][e] * qv[ks][e]; }
      ss += __shfl_xor(ss, 16); ss += __shfl_xor(ss, 32);
      const float rs = rsqrtf(ss * (1.0f / 128.0f) + EPS) * 0.08838834764831845f; const float* qg = P_sb_q_norm + l * 128 + 8 * kq;
#pragma unroll
      for (int ks = 0; ks < 4; ++ks) { v4u p; p.x = pk2(qv[ks][0] * rs * qg[32 * ks], qv[ks][1] * rs * qg[32 * ks + 1]); p.y = pk2(qv[ks][2] * rs * qg[32 * ks + 2], qv[ks][3] * rs * qg[32 * ks + 3]);
          p.z = pk2(qv[ks][4] * rs * qg[32 * ks + 4], qv[ks][5] * rs * qg[32 * ks + 5]); p.w = pk2(qv[ks][6] * rs * qg[32 * ks + 6], qv[ks][7] * rs * qg[32 * ks + 7]); qf[ks] = __builtin_bit_cast(bf16x8, p); } }
    f32x4 oacc[8];
#pragma unroll
    for (int i = 0; i < 8; ++i) oacc[i] = (f32x4){0.f, 0.f, 0.f, 0.f};
    float accrow = 0.f;
    v4u kraw[2], vraw[2];
    { const bf16* kp = W_PROJ + (size_t)(64 * (2 * qb + 1) + (tid >> 3)) * NPROJ + C_SBQKV + 512 + hh * 128 + 16 * (tid & 7);
      kraw[0] = *(const v4u*)kp; kraw[1] = *(const v4u*)(kp + 8); vraw[0] = *(const v4u*)(kp + 512); vraw[1] = *(const v4u*)(kp + 520); }
    for (int jb = 2 * qb + 1; jb >= 0; --jb) {
        { const int kr = tid >> 3, k8 = tid & 7; float kv[16]; float ss = 0.f;
          const v4u v0 = vraw[0], v1 = vraw[1];
          unpack8(kraw[0], kv); unpack8(kraw[1], kv + 8);
#pragma unroll
          for (int e = 0; e < 16; ++e) ss += kv[e] * kv[e];
          ss += __shfl_xor(ss, 1); ss += __shfl_xor(ss, 2); ss += __shfl_xor(ss, 4);
          const float rk = rsqrtf(ss * (1.0f / 128.0f) + EPS); const float* kg = P_sb_k_norm + l * 128 + 16 * k8;
          v4u o0, o1; o0.x = pk2(kv[0] * rk * kg[0], kv[1] * rk * kg[1]); o0.y = pk2(kv[2] * rk * kg[2], kv[3] * rk * kg[3]); o0.z = pk2(kv[4] * rk * kg[4], kv[5] * rk * kg[5]); o0.w = pk2(kv[6] * rk * kg[6], kv[7] * rk * kg[7]);
          o1.x = pk2(kv[8] * rk * kg[8], kv[9] * rk * kg[9]); o1.y = pk2(kv[10] * rk * kg[10], kv[11] * rk * kg[11]); o1.z = pk2(kv[12] * rk * kg[12], kv[13] * rk * kg[13]); o1.w = pk2(kv[14] * rk * kg[14], kv[15] * rk * kg[15]);
          *(LAS v4u*)(Ks + kr * 136 + 16 * k8) = o0; *(LAS v4u*)(Ks + kr * 136 + 16 * k8 + 8) = o1;
          const int sp = (kr & ~31) + 8 * ((kr >> 2) & 3) + 4 * ((kr >> 4) & 1) + (kr & 3);
          const unsigned vw[8] = {v0.x, v0.y, v0.z, v0.w, v1.x, v1.y, v1.z, v1.w};
#pragma unroll
          for (int e = 0; e < 8; ++e) { VT[(16 * k8 + 2 * e) * 72 + sp] = (bf16)(vw[e] & 0xffffu); VT[(16 * k8 + 2 * e + 1) * 72 + sp] = (bf16)(vw[e] >> 16); } }
        __syncthreads();
        if (jb > 0) { const bf16* kp = W_PROJ + (size_t)(64 * (jb - 1) + (tid >> 3)) * NPROJ + C_SBQKV + 512 + hh * 128 + 16 * (tid & 7);
            kraw[0] = *(const v4u*)kp; kraw[1] = *(const v4u*)(kp + 8); vraw[0] = *(const v4u*)(kp + 512); vraw[1] = *(const v4u*)(kp + 520); }
        if (64 * jb <= q0 + 16 * w + 15) {
            f32x4 st[4];
#pragma unroll
            for (int i = 0; i < 4; ++i) { f32x4 d = (f32x4){0.f, 0.f, 0.f, 0.f};
#pragma unroll
                for (int ks = 0; ks < 4; ++ks) { const bf16x8 a = *(const LAS bf16x8*)(Ks + (16 * i + r16) * 136 + 32 * ks + 8 * kq); d = MFMA16(a, qf[ks], d); }
                st[i] = d; }
            float carry = accrow; unsigned pw[4][2];
#pragma unroll
            for (int i = 3; i >= 0; --i) { float lb[4], lk[4];
#pragma unroll
                for (int j = 0; j < 4; ++j) { const float z = st[i][j]; const bool valid = (64 * jb + 16 * i + 4 * kq + j) < tg;
                    const float b = fminf(z, 0.f) - __logf(1.0f + __expf(-fabsf(z))); lb[j] = valid ? b : -INFINITY; lk[j] = valid ? b - z : 0.f; }
                const float q = (lk[0] + lk[1]) + (lk[2] + lk[3]);
                const float v1 = __shfl_xor(q, 16), v2 = __shfl_xor(q, 32), v3 = __shfl_xor(v1, 32);
                const float hi = kq == 0 ? (v1 + v2 + v3) : (kq == 1 ? (v2 + v3) : (kq == 2 ? v1 : 0.f));
                const float base = carry + hi;
                const float p3 = __expf(lb[3] + base), p2 = __expf(lb[2] + base + lk[3]), p1 = __expf(lb[1] + base + lk[3] + lk[2]), p0 = __expf(lb[0] + base + lk[3] + lk[2] + lk[1]);
                pw[i][0] = pk2(p0, p1); pw[i][1] = pk2(p2, p3);
                carry += (q + v1) + (v2 + v3); }
            accrow = carry;
#pragma unroll
            for (int k2 = 0; k2 < 2; ++k2) { v4u pp; pp.x = pw[2 * k2][0]; pp.y = pw[2 * k2][1]; pp.z = pw[2 * k2 + 1][0]; pp.w = pw[2 * k2 + 1][1]; const bf16x8 pf = __builtin_bit_cast(bf16x8, pp);
#pragma unroll
                for (int dt = 0; dt < 8; ++dt) { const bf16x8 a = *(const LAS bf16x8*)(VT + (16 * dt + r16) * 72 + 32 * k2 + 8 * kq); oacc[dt] = MFMA16(a, pf, oacc[dt]); } }
        }
        float mx = accrow;
#pragma unroll
        for (int of = 1; of < 64; of <<= 1) mx = fmaxf(mx, __shfl_xor(mx, of));
        if (lane == 0) red[w] = mx;
        __syncthreads();
        float m = red[0];
#pragma unroll
        for (int i = 1; i < 8; ++i) m = fmaxf(m, red[i]);
        if (m < -104.0f) break;
    }
    bf16* op = W_YBR + (size_t)SEQ * 512 + (size_t)tg * 512 + hh * 128 + 4 * kq;
#pragma unroll
    for (int dt = 0; dt < 8; ++dt) { v2u o; o.x = pk2(oacc[dt][0], oacc[dt][1]); o.y = pk2(oacc[dt][2], oacc[dt][3]); *(v2u*)(op + 16 * dt) = o; }
    __syncthreads();
}
__device__ __forceinline__ void phase_mix1(Frame& F, int l) {
    if (F.vcu < 32) ssd_scan(F);
    else if (F.vcu < 160) { const int u = F.vcu - 32; gdn_seg<1>(F, u >> 5, (u >> 1) & 15, u & 1); }
    LAS int* nxt = (LAS int*)(F.lds + MISC_OFF + 512);
    for (;;) {
        __syncthreads();
        if (F.tid == 0) *nxt = (int)atomicAdd(F.ctl + CW_SBQ + l * 64, 1u);
        __syncthreads();
        const int u = *nxt; if (u >= 512) break;
        sb_mfma_unit(F, l, u & 3, 127 - (u >> 2));
    }
}
__device__ __forceinline__ void phase_mix2(Frame& F, int l) {
    if (F.vcu < 8) gdn_seg<2>(F, F.vcu >> 1, 0, F.vcu & 1);
    else ssd_phase_e(F, l, F.vcu - 8, 248, F.G);
}
__device__ __forceinline__ void phase_mix3(Frame& F, int l) {
    if (F.vcu < 128) gdn_seg<3>(F, F.vcu >> 5, (F.vcu >> 1) & 15, F.vcu & 1);
    else if (F.vcu < 136) ssd_phase_e(F, l, 248 + F.vcu - 128, 256, 8);
}

__device__ __forceinline__ void phase_final(Frame& F) {
    const int lane = F.lane, gw = F.vcu * NWAVES + F.wave, NGW = F.G * NWAVES;
    f32x4 G4[4];
#pragma unroll
    for (int j = 0; j < 4; ++j) G4[j] = modv4<true>(F, NL - 1, 5, j * 256 + 4 * lane);
    LAS int* ttab = (LAS int*)(F.lds + MISC_OFF + 3072); build_tile_table(F, NL - 1, ttab);
    for (int m = gw; m < SEQ; m += NGW) {
        const int s0 = ttab[W_PAIRE[2 * m]] * 256 + W_PAIRS[2 * m], s1 = ttab[W_PAIRE[2 * m + 1]] * 256 + W_PAIRS[2 * m + 1]; const float w0 = W_PAIRW[2 * m], w1 = W_PAIRW[2 * m + 1];
        const v2u* y0 = (const v2u*)(W_YP + (size_t)s0 * 1024); const v2u* y1 = (const v2u*)(W_YP + (size_t)s1 * 1024);
#pragma unroll
        for (int j = 0; j < 4; ++j) { const v2u a = y0[64 * j + lane], b = y1[64 * j + lane]; f32x4 v = ((const f32x4*)(F.out + (size_t)m * 1024))[64 * j + lane];
            f32x4 y; y[0] = w0 * bflo(a.x) + w1 * bflo(b.x); y[1] = w0 * bfhi(a.x) + w1 * bfhi(b.x); y[2] = w0 * bflo(a.y) + w1 * bflo(b.y); y[3] = w0 * bfhi(a.y) + w1 * bfhi(b.y);
            ((f32x4*)(F.out + (size_t)m * 1024))[64 * j + lane] = v + G4[j] * y; }
    }
}

struct Args { const float* in[28]; float* out; unsigned char* ws; int ph_lo, ph_hi, li, pad; };
__global__ void __launch_bounds__(NWAVES * 64, 2) mk_fwd(Args args) {
    extern __shared__ __attribute__((aligned(16))) unsigned char lds[];
    Frame F;
    F.lds = (LAS unsigned char*)lds;
    F.tid = threadIdx.x; F.lane = F.tid & 63; F.wave = __builtin_amdgcn_readfirstlane(F.tid >> 6);
    F.G = gridDim.x; { const int bx = blockIdx.x; F.vcu = (F.G % 8 == 0) ? (bx % 8) * (F.G / 8) + bx / 8 : bx; }
    F.ws = args.ws; F.in = args.in; F.out = args.out;
    F.ctl = (unsigned*)(F.ws + WS_CTL);
    volatile LAS unsigned* MISC = (volatile LAS unsigned*)(F.lds + MISC_OFF);
    for (int u = F.tid; u < 128; u += NWAVES * 64) MISC[u] = 0u;
    __syncthreads();
    const int lo = args.ph_lo, hi = args.ph_hi; const int vcu0 = F.vcu;
    XcdBarrier bar; bar.bar = F.ctl + CW_BAR + args.li * XCD_BAR_WORDS; bar.x = 0; bar.st = nullptr;
    if (hi - lo > 1) bar = xcd_barrier_post(F.ctl + CW_BAR + args.li * XCD_BAR_WORDS, MISC + 8);
#define IN(k) (lo <= (k) && (k) < hi)
#define FRESH() do { int t_ = threadIdx.x; asm volatile("" : "+v"(t_)); F.tid = t_; F.lane = t_ & 63; F.wave = __builtin_amdgcn_readfirstlane(t_ >> 6); \
        int v_ = vcu0, g_ = (int)gridDim.x; asm volatile("" : "+s"(v_), "+s"(g_)); F.vcu = v_; F.G = g_; \
        } while (0)
#define SEAM(k) do { if ((k) + 1 < hi) xcd_barrier(bar); } while (0)

    if (IN(0)) { FRESH(); p0_prologue(F); SEAM(0); }
    for (int l = 0; l < NL; ++l) {
        const int pb = 1 + 13 * l;
        if (IN(pb + 0)) { FRESH(); phase_norm<false>(F, l); SEAM(pb + 0); }
        if (IN(pb + 1)) { FRESH();
            pg8::Gemm g{W_HB, W_WIN + (size_t)l * 8192 * 1024, 1024, 0, 0}; pg8::StaticOrder S; S.init(SEQ, 8192, F.G, (int)blockIdx.x);
            pg8::EpiProj E{W_PROJ, NPROJ, C_BRG / 256, W_GATES};
            pg8::gemm_phase(F.lds, g, S, E); SEAM(pb + 1); }
        if (IN(pb + 2)) { FRESH(); gdn_phase_x(F, l); FRESH(); ssd_phase_c(F, l); SEAM(pb + 2); }
        if (IN(pb + 3)) { FRESH(); phase_mix1(F, l); SEAM(pb + 3); }
        if (IN(pb + 4)) { FRESH(); phase_mix2(F, l); SEAM(pb + 4); }
        if (IN(pb + 5)) { FRESH(); phase_mix3(F, l); SEAM(pb + 5); }
        if (IN(pb + 6)) { FRESH(); gdn_phase_z(F, l); SEAM(pb + 6); }
        if (IN(pb + 7)) { FRESH();
            pg8::Gemm g{W_YBR, W_WBR + (size_t)l * 3 * 1024 * 512, 512, (size_t)SEQ * 512 * 2, (size_t)1024 * 512 * 2}; pg8::BranchOrder S; S.so.init(SEQ, 1024, F.G, (int)blockIdx.x);
            pg8::EpiBranch E{W_GATES, W_MERGED};
            pg8::gemm_phase(F.lds, g, S, E); SEAM(pb + 7); }
        if (IN(pb + 8)) { FRESH();
            pg8::Gemm g{W_MERGED, W_WOUT + (size_t)l * 1024 * 1024, 1024, 0, 0}; pg8::StaticOrder S; S.init(SEQ, 1024, F.G, (int)blockIdx.x);
            pg8::EpiOut E{l == 0 ? P_x : F.out, F.out, W_MODF + l * 6144 + 2 * 1024};
            pg8::gemm_phase(F.lds, g, S, E); SEAM(pb + 8); }
        if (IN(pb + 9)) { FRESH(); phase_norm<true>(F, l); SEAM(pb + 9); }
        if (IN(pb + 11)) { FRESH();
            LAS int* tab = (LAS int*)(F.lds + MISC_OFF + 3072); const int nt = build_tile_table(F, l, tab);
            pg8::Gemm g{W_HB, W_WGU + (size_t)l * 32 * 1024 * 1024, 1024, 0, (size_t)1024 * 1024 * 2}; pg8::ExpertOrder S{tab, F.G, F.vcu, nt};
            pg8::EpiAct E{W_ACT}; pg8::Gather GI{W_TOKOF, tab, tab + 64};
            pg8::gemm_phase<pg8::EpiAct, pg8::ExpertOrder, true>(F.lds, g, S, E, GI); SEAM(pb + 11); }
        if (IN(pb + 12)) { FRESH();
            LAS int* tab = (LAS int*)(F.lds + MISC_OFF + 3072); const int nt = build_tile_table(F, l, tab);
            pg8::Gemm g{W_ACT, W_WD + (size_t)l * 32 * 1024 * 512, 512, 0, (size_t)1024 * 512 * 2}; pg8::ExpertOrder S{tab, F.G, F.vcu, nt};
            pg8::EpiBf16 E{W_YP};
            pg8::gemm_phase(F.lds, g, S, E); SEAM(pb + 12); }
    }
    if (IN(53)) { FRESH(); phase_final(F); }
#undef IN
#undef SEAM
}

extern "C" void kernel_launch(void* const* d_in, const int* in_sizes, int n_in, void* d_out, int out_size, void* d_ws, size_t ws_size, hipStream_t stream) {
    static int grid = 0;
    if (grid == 0) {
        if (n_in != 28 || in_sizes[0] != SEQ * DM || out_size != SEQ * DM || ws_size < WS_END) {
            fprintf(stderr, "kernel_launch: built for 28 inputs, x/out of %d floats, >= %zu bytes of workspace; got n_in %d in0 %d out %d ws %zu\n", SEQ * DM, (size_t)WS_END, n_in, n_in > 0 ? in_sizes[0] : -1, out_size, ws_size); grid = -1; return; }
        int dev = 0, cus = 0, per_cu = 0;
        if (hipGetDevice(&dev) != hipSuccess || hipDeviceGetAttribute(&cus, hipDeviceAttributeMultiprocessorCount, dev) != hipSuccess) { fprintf(stderr, "kernel_launch: device query failed\n"); grid = -1; return; }
        if (hipFuncSetAttribute((const void*)mk_fwd, hipFuncAttributeMaxDynamicSharedMemorySize, LDS_BYTES) != hipSuccess) { fprintf(stderr, "kernel_launch: hipFuncSetAttribute failed\n"); grid = -1; return; }
        if (hipOccupancyMaxActiveBlocksPerMultiprocessor(&per_cu, (const void*)mk_fwd, NWAVES * 64, LDS_BYTES) != hipSuccess || per_cu < 1)
            fprintf(stderr, "kernel_launch: occupancy query reports %d workgroups per CU\n", per_cu);
        (void)hipGetLastError();
        grid = cus;
    }
    if (grid < 0) return;
    if (hipMemsetAsync((char*)d_ws + WS_CTL, 0, CTL_ZERO_BYTES, stream) != hipSuccess) { fprintf(stderr, "kernel_launch: memset failed\n"); return; }
    Args a{};
    for (int i = 0; i < 28; ++i) a.in[i] = (const float*)d_in[i];
    a.out = (float*)d_out; a.ws = (unsigned char*)d_ws; a.pad = 0;
#if MK_SPLIT
    for (int p = 0; p < N_PHASES; ++p) { a.ph_lo = p; a.ph_hi = p + 1; a.li = 0;
        hipLaunchKernelGGL(mk_fwd, dim3(grid), dim3(NWAVES * 64), LDS_BYTES, stream, a);
        const hipError_t le = hipPeekAtLastError();
        if (le != hipSuccess) { fprintf(stderr, "kernel_launch: launch %d failed: %s\n", p, hipGetErrorName(le)); break; } }
#else
    a.ph_lo = 0; a.ph_hi = N_PHASES; a.li = 0;
    hipLaunchKernelGGL(mk_fwd, dim3(grid), dim3(NWAVES * 64), LDS_BYTES, stream, a);
    const hipError_t le = hipPeekAtLastError();
    if (le != hipSuccess) fprintf(stderr, "kernel_launch: launch failed: %s\n", hipGetErrorName(le));
#endif
}
```

```cpp
#include <hip/hip_runtime.h>
#include <cstdio>
#include <cstdint>

#ifndef MK_SPLIT
#define MK_SPLIT 0
#endif

namespace pg8 {
#define PG8_LAS __attribute__((address_space(3)))
typedef unsigned short bf16_t;
typedef short bf16x8 __attribute__((ext_vector_type(8)));
typedef float f32x4 __attribute__((ext_vector_type(4)));
typedef unsigned u32x4 __attribute__((ext_vector_type(4)));
typedef unsigned u32x2 __attribute__((ext_vector_type(2)));
constexpr int BM = 256, BK = 64, HALF = 128, HTB = HALF * BK * 2, STAGE_BYTES = 8 * HTB, NXCD = 8, WGM = 8;

__host__ __device__ __forceinline__ int lds_byte(int r, int c) { const int st = (r >> 4) * 2 + (c >> 5), rr = r & 15, cc = c & 31, ob = rr * 64 + cc * 2; return st * 1024 + (ob ^ (((ob >> 9) & 1) << 5)); }
__host__ __device__ __forceinline__ void stage_rc(int b, int& R, int& C) { const int st = b / 1024, sb = b % 1024, swz = sb ^ (((sb >> 9) & 1) << 5); R = (st >> 1) * 16 + swz / 64; C = (st & 1) * 32 + (swz % 64) / 2; }
__host__ __device__ __forceinline__ int perm32(int rho) { const int n = rho >> 4, i = rho & 15; return 8 * (i >> 2) + 4 * n + (i & 3); }

struct Unit { int pm, pn, z; };
struct Gemm { const bf16_t* A; const bf16_t* Bt; int K; size_t zsA, zsB; };

struct StaticOrder {
    int nM, nN, nwg, G, c;
    __host__ __device__ void init(int M, int N, int G_, int c_) { nM = M / BM; nN = N / BM; nwg = nM * nN; G = G_; c = c_; }
    __host__ __device__ bool map(long L, Unit& u) const {
        if (L >= nwg) return false;
        int wgid = (int)L; { const int q = nwg / NXCD, r = nwg % NXCD, xcd = wgid % NXCD, off = wgid / NXCD; wgid = (xcd < r ? xcd * (q + 1) : r * (q + 1) + (xcd - r) * q) + off; }
        const int nig = WGM * nN, gid = wgid / nig, fm = gid * WGM, gsz = (nM - fm) < WGM ? (nM - fm) : WGM;
        u.pm = fm + ((wgid % nig) % gsz); u.pn = (wgid % nig) / gsz; u.z = 0; return true;
    }
    __host__ __device__ bool next(int i, Unit& u) const { return map((long)i * G + c, u); }
};
struct BranchOrder {
    StaticOrder so;
    __device__ bool next(int i, Unit& u) const { const int rd = i / 3; const bool ok = so.map((long)rd * so.G + so.c, u); u.z = i - 3 * rd; return ok; }
};
struct ExpertOrder {
    const PG8_LAS int* tab; int G, c, ntiles;
    __device__ bool next(int i, Unit& u) const {
        const int L = i * G + c, rt = L >> 2; if (rt >= ntiles) return false;
        int e = 0; const PG8_LAS int* tb = tab; asm volatile("" : "+v"(tb));
        for (int k = 1; k < 32; ++k) e += (tb[k] <= rt) ? 1 : 0;
        e = __builtin_amdgcn_readfirstlane(e);
        u.pm = rt; u.pn = L & 3; u.z = e; return true;
    }
};

__device__ __forceinline__ unsigned cvt_pk_bf16(float lo, float hi) { unsigned r; asm volatile("v_cvt_pk_bf16_f32 %0, %1, %2" : "=v"(r) : "v"(lo), "v"(hi)); return r; }
__device__ __forceinline__ float fsigmoid(float x) { return __builtin_amdgcn_rcpf(1.0f + __expf(-x)); }

struct EpiProj {
    static constexpr bool PERM = true;
    __device__ __forceinline__ bool keep(const Unit&) const { return false; }
    bf16_t* O; int ldc; int sig_pn; bf16_t* gates;
    __device__ __forceinline__ void operator()(const f32x4 (&acc)[2][2][4][2], const Unit& u, int wr, int wc, int fr, int fq) const {
        const int row0 = u.pm * BM + wr * 64 + fr, col0 = u.pn * BM + wc * 32 + 8 * fq; const bool sg = u.pn >= sig_pn;
        if (!sg) {
#pragma unroll
            for (int ai = 0; ai < 2; ++ai)
#pragma unroll
                for (int m = 0; m < 4; ++m) { bf16_t* rowp = O + (size_t)(row0 + ai * HALF + m * 16) * ldc + col0;
#pragma unroll
                    for (int bj = 0; bj < 2; ++bj) { const f32x4 v0 = acc[ai][bj][m][0], v1 = acc[ai][bj][m][1];
                        u32x4 w; w.x = cvt_pk_bf16(v0[0], v0[1]); w.y = cvt_pk_bf16(v0[2], v0[3]); w.z = cvt_pk_bf16(v1[0], v1[1]); w.w = cvt_pk_bf16(v1[2], v1[3]);
                        *(u32x4*)(rowp + bj * HALF) = w; } }
        } else { const int z = (u.pn - sig_pn) >> 2, pq = (u.pn - sig_pn) & 3;
            bf16_t* gb = gates + ((((size_t)(z * 64 + u.pm) * 4 + pq) * 2 + wr) * 4 + wc) * 2 * 4 * 64 * 16 + (size_t)((2 * (fq & 1)) * 16 + fr) * 16 + (fq >> 1) * 4;
#pragma unroll
            for (int ai = 0; ai < 2; ++ai)
#pragma unroll
                for (int m = 0; m < 4; ++m)
#pragma unroll
                    for (int bj = 0; bj < 2; ++bj) { f32x4 v0 = acc[ai][bj][m][0], v1 = acc[ai][bj][m][1];
#pragma unroll
                        for (int j = 0; j < 4; ++j) { v0[j] = fsigmoid(v0[j]); v1[j] = fsigmoid(v1[j]); }
                        bf16_t* p = gb + (size_t)(ai * 4 + m) * 64 * 16 + bj * 8;
                        u32x2 w0, w1; w0.x = cvt_pk_bf16(v0[0], v0[1]); w0.y = cvt_pk_bf16(v0[2], v0[3]); w1.x = cvt_pk_bf16(v1[0], v1[1]); w1.y = cvt_pk_bf16(v1[2], v1[3]);
                        *(u32x2*)p = w0; *(u32x2*)(p + 16 * 16) = w1; } }
    }
};
struct EpiAct {
    static constexpr bool PERM = true;
    __device__ __forceinline__ bool keep(const Unit&) const { return false; }
    bf16_t* O;
    __device__ __forceinline__ void operator()(const f32x4 (&acc)[2][2][4][2], const Unit& u, int wr, int wc, int fr, int fq) const {
        const int row0 = u.pm * BM + wr * 64 + fr, col0 = u.pn * HALF + wc * 32 + 8 * fq;
#pragma unroll
        for (int ai = 0; ai < 2; ++ai)
#pragma unroll
            for (int m = 0; m < 4; ++m) { bf16_t* rowp = O + (size_t)(row0 + ai * HALF + m * 16) * 512 + col0;
                f32x4 a0, a1;
#pragma unroll
                for (int j = 0; j < 4; ++j) { const float g0 = acc[ai][0][m][0][j], g1 = acc[ai][0][m][1][j];
                    a0[j] = g0 * fsigmoid(g0) * acc[ai][1][m][0][j]; a1[j] = g1 * fsigmoid(g1) * acc[ai][1][m][1][j]; }
                u32x4 w; w.x = cvt_pk_bf16(a0[0], a0[1]); w.y = cvt_pk_bf16(a0[2], a0[3]); w.z = cvt_pk_bf16(a1[0], a1[1]); w.w = cvt_pk_bf16(a1[2], a1[3]);
                *(u32x4*)rowp = w; }
    }
};
struct EpiOut {
    static constexpr bool PERM = false;
    __device__ __forceinline__ bool keep(const Unit&) const { return false; }
    const float* base; float* out; const float* gate;
    __device__ __forceinline__ void operator()(const f32x4 (&acc)[2][2][4][2], const Unit& u, int wr, int wc, int fr, int fq) const {
        const int row0 = u.pm * BM + wr * 64 + fr, col0 = u.pn * BM + wc * 32 + 4 * fq;
        f32x4 gv[2][2];
#pragma unroll
        for (int bj = 0; bj < 2; ++bj)
#pragma unroll
            for (int n = 0; n < 2; ++n) gv[bj][n] = *(const f32x4*)(gate + col0 + bj * HALF + n * 16);
#pragma unroll
        for (int ai = 0; ai < 2; ++ai)
#pragma unroll
            for (int m = 0; m < 4; ++m) { const size_t off = (size_t)(row0 + ai * HALF + m * 16) * 1024 + col0;
#pragma unroll
                for (int bj = 0; bj < 2; ++bj)
#pragma unroll
                    for (int n = 0; n < 2; ++n) { const f32x4 b = *(const f32x4*)(base + off + bj * HALF + n * 16);
                        *(f32x4*)(out + off + bj * HALF + n * 16) = b + gv[bj][n] * acc[ai][bj][m][n]; }
                if (m & 1) asm volatile("" ::: "memory"); }
    }
};
struct EpiBranch {
    static constexpr bool PERM = false;
    const bf16_t* gates; bf16_t* merged;
    __device__ __forceinline__ bool keep(const Unit& u) const { return u.z < 2; }
    __device__ __forceinline__ void operator()(f32x4 (&acc)[2][2][4][2], const Unit& u, int wr, int wc, int fr, int fq) const {
        const int row0 = u.pm * BM + wr * 64 + fr, col0 = u.pn * BM + wc * 32 + 4 * fq; const float tiny = 8.673617379884035e-19f;
        const bf16_t* gb = gates + ((((size_t)(u.z * 64 + u.pm) * 4 + u.pn) * 2 + wr) * 4 + wc) * 2 * 4 * 64 * 16 + (size_t)(fq * 16 + fr) * 16;
        const size_t zs = (size_t)64 * 4 * 2 * 4 * 2 * 4 * 64 * 16;
#pragma unroll
        for (int ai = 0; ai < 2; ++ai)
#pragma unroll
            for (int m = 0; m < 4; ++m) { const size_t off = (size_t)(row0 + ai * HALF + m * 16) * 1024 + col0; const bf16_t* gp = gb + (size_t)(ai * 4 + m) * 64 * 16;
                const u32x4 ga = *(const u32x4*)gp, gbv = *(const u32x4*)(gp + 8); u32x4 ha = ga, hb = gbv;
                if (u.z < 2) { ha = *(const u32x4*)(gp + zs); hb = *(const u32x4*)(gp + zs + 8); }
                const unsigned gw[8] = {ga.x, ga.y, ga.z, ga.w, gbv.x, gbv.y, gbv.z, gbv.w}, hw[8] = {ha.x, ha.y, ha.z, ha.w, hb.x, hb.y, hb.z, hb.w};
#pragma unroll
                for (int bj = 0; bj < 2; ++bj)
#pragma unroll
                    for (int n = 0; n < 2; ++n) { const int q = (bj * 2 + n) * 2; const int co = bj * HALF + n * 16;
                        f32x4 g; g[0] = __uint_as_float(gw[q] << 16); g[1] = __uint_as_float(gw[q] & 0xffff0000u); g[2] = __uint_as_float(gw[q + 1] << 16); g[3] = __uint_as_float(gw[q + 1] & 0xffff0000u);
#pragma unroll
                        for (int j = 0; j < 4; ++j) g[j] = fmaxf(g[j], tiny);
                        if (u.z < 2) { f32x4 h; h[0] = __uint_as_float(hw[q] << 16); h[1] = __uint_as_float(hw[q] & 0xffff0000u); h[2] = __uint_as_float(hw[q + 1] << 16); h[3] = __uint_as_float(hw[q + 1] & 0xffff0000u);
#pragma unroll
                            for (int j = 0; j < 4; ++j) g[j] *= __builtin_amdgcn_rcpf(fmaxf(h[j], tiny));
                            acc[ai][bj][m][n] = acc[ai][bj][m][n] * g; }
                        else { const f32x4 t = acc[ai][bj][m][n] * g; u32x2 w; w.x = cvt_pk_bf16(t[0], t[1]); w.y = cvt_pk_bf16(t[2], t[3]); *(u32x2*)(merged + off + co) = w; } }
                if ((m & 3) == 3) asm volatile("" ::: "memory"); }
    }
};
struct EpiBf16 {
    static constexpr bool PERM = true;
    __device__ __forceinline__ bool keep(const Unit&) const { return false; }
    bf16_t* O;
    __device__ __forceinline__ void operator()(const f32x4 (&acc)[2][2][4][2], const Unit& u, int wr, int wc, int fr, int fq) const {
        const int row0 = u.pm * BM + wr * 64 + fr, col0 = u.pn * BM + wc * 32 + 8 * fq;
#pragma unroll
        for (int ai = 0; ai < 2; ++ai)
#pragma unroll
            for (int m = 0; m < 4; ++m) { bf16_t* rowp = O + (size_t)(row0 + ai * HALF + m * 16) * 1024 + col0;
#pragma unroll
                for (int bj = 0; bj < 2; ++bj) { const f32x4 v0 = acc[ai][bj][m][0], v1 = acc[ai][bj][m][1];
                    u32x4 w; w.x = cvt_pk_bf16(v0[0], v0[1]); w.y = cvt_pk_bf16(v0[2], v0[3]); w.z = cvt_pk_bf16(v1[0], v1[1]); w.w = cvt_pk_bf16(v1[2], v1[3]);
                    *(u32x4*)(rowp + bj * HALF) = w; } }
    }
};

struct Gather { const int* tokof; const PG8_LAS int* tab; const PG8_LAS int* cnt; };
template <class Epi, class Sched, bool GATHER = false>
__device__ __forceinline__ void gemm_phase(PG8_LAS unsigned char* lds, const Gemm g, const Sched& S, const Epi& E, const Gather G = Gather{nullptr, nullptr, nullptr}) {
    int tid_ = threadIdx.x; asm volatile("" : "+v"(tid_));
    const int tid = tid_, wid = __builtin_amdgcn_readfirstlane(tid >> 6), lane = tid & 63, wr = wid >> 2, wc = wid & 3, fr = lane & 15, fq = lane >> 4;
    const int K = g.K, nt = K / BK;
    unsigned voffA[2], voffB[2]; int gR[2]; unsigned gC[2];
#pragma unroll
    for (int i = 0; i < 2; ++i) { int R, C; stage_rc(tid * 16 + i * 8192, R, C); const int Rb = Epi::PERM ? ((R & ~31) + perm32(R & 31)) : R;
        voffA[i] = (unsigned)(R * K + C) * 2u; voffB[i] = (unsigned)(Rb * K + C) * 2u; gR[i] = R; gC[i] = (unsigned)C * 2u; }
    unsigned gA[2][2], gN[2][2];
#define PG8_GLOAD(dst, u) do { const int e_ = (u).z, base_ = ((u).pm - G.tab[e_]) * 256, cn_ = G.cnt[e_]; _Pragma("unroll") for (int h_ = 0; h_ < 2; ++h_) _Pragma("unroll") for (int i_ = 0; i_ < 2; ++i_) { \
        const int pos_ = base_ + h_ * 128 + gR[i_]; const int tk_ = pos_ < cn_ ? G.tokof[e_ * 16384 + pos_] : 0; dst[h_][i_] = (unsigned)tk_ * (unsigned)(K * 2) + gC[i_]; } } while (0)
    const size_t kstep = (size_t)(BK * 2);
    const size_t hstep = (size_t)HALF * K * 2;
    const size_t tstep = 2 * hstep;
    const unsigned ldsw = (unsigned)wid * 1024u;
    const int aoff = lds_byte(wr * 64 + fr, fq * 8), boff = lds_byte(wc * 32 + fr, fq * 8);
#define PG8_SA(b, h) (((b) * 2 + (h)) * HTB)
#define PG8_SB(b, h) ((4 + (b) * 2 + (h)) * HTB)
#define PG8_STAGE(bufoff, gbase, voff) do { _Pragma("unroll") for (int _i = 0; _i < 2; ++_i) \
        __builtin_amdgcn_global_load_lds((const unsigned*)((const char*)(gbase) + (voff)[_i]), (PG8_LAS unsigned*)(lds + (bufoff) + ldsw + _i * 8192), 16, 0, 0); } while (0)
#define PG8_LDA(dst, b, h) do { _Pragma("unroll") for (int m = 0; m < 4; ++m) _Pragma("unroll") for (int k = 0; k < 2; ++k) dst[m][k] = *(const PG8_LAS bf16x8*)(lds + PG8_SA(b, h) + aoff + m * 2048 + k * 1024); } while (0)
#define PG8_LDB(dst, b, h) do { _Pragma("unroll") for (int n = 0; n < 2; ++n) _Pragma("unroll") for (int k = 0; k < 2; ++k) dst[n][k] = *(const PG8_LAS bf16x8*)(lds + PG8_SB(b, h) + boff + n * 2048 + k * 1024); } while (0)
#define PG8_MMA(ai, bj, At, Bt) do { __builtin_amdgcn_s_setprio(1); _Pragma("unroll") for (int m = 0; m < 4; ++m) _Pragma("unroll") for (int n = 0; n < 2; ++n) _Pragma("unroll") for (int k = 0; k < 2; ++k) \
        acc[ai][bj][m][n] = __builtin_amdgcn_mfma_f32_16x16x32_bf16(Bt[n][k], At[m][k], acc[ai][bj][m][n], 0, 0, 0); __builtin_amdgcn_s_setprio(0); } while (0)
#define PG8_WAIT_V(n) asm volatile("s_waitcnt vmcnt(" #n ")" ::: "memory")
#define PG8_WAIT_L(n) asm volatile("s_waitcnt lgkmcnt(" #n ")" ::: "memory")
#define PG8_BAR __builtin_amdgcn_s_barrier()
#define PG8_SCHED __builtin_amdgcn_sched_barrier(0)
    Unit cur, nxt; int ui = 0;
    if (!S.next(0, cur)) return;
    f32x4 acc[2][2][4][2];
#pragma unroll
    for (int a = 0; a < 2; ++a)
#pragma unroll
        for (int b = 0; b < 2; ++b)
#pragma unroll
            for (int m = 0; m < 4; ++m)
#pragma unroll
                for (int n = 0; n < 2; ++n) acc[a][b][m][n] = (f32x4){0.f, 0.f, 0.f, 0.f};
    bf16x8 At[4][2], B0[2][2], B1[2][2];
    const char* cA = GATHER ? (const char*)g.A : (const char*)g.A + (size_t)cur.z * g.zsA + (size_t)cur.pm * tstep; const char* cB = (const char*)g.Bt + (size_t)cur.z * g.zsB + (size_t)cur.pn * tstep;
    const size_t hA = GATHER ? 0 : hstep;
    if (GATHER) { PG8_GLOAD(gA, cur); } else { gA[0][0] = voffA[0]; gA[0][1] = voffA[1]; gA[1][0] = voffA[0]; gA[1][1] = voffA[1]; }
#pragma unroll
    for (int h = 0; h < 2; ++h) { gN[h][0] = gA[h][0]; gN[h][1] = gA[h][1]; }
    PG8_STAGE(PG8_SB(0, 0), cB, voffB); PG8_STAGE(PG8_SB(0, 1), cB + hstep, voffB); PG8_STAGE(PG8_SA(0, 0), cA, gA[0]); PG8_STAGE(PG8_SA(0, 1), cA + hA, gA[1]);
    if (wr == 1) PG8_BAR;
    PG8_WAIT_V(2); PG8_BAR;
    PG8_STAGE(PG8_SB(1, 0), cB + kstep, voffB); PG8_STAGE(PG8_SA(1, 0), cA + kstep, gA[0]); PG8_STAGE(PG8_SB(1, 1), cB + hstep + kstep, voffB);
    PG8_WAIT_V(6); PG8_BAR;
    for (;;) {
        const bool has_next = S.next(ui + 1, nxt);
        if (GATHER && has_next) { PG8_GLOAD(gN, nxt); }
        const char* nA = GATHER ? cA : (has_next ? (const char*)g.A + (size_t)nxt.z * g.zsA + (size_t)nxt.pm * tstep : cA); const char* nB = has_next ? (const char*)g.Bt + (size_t)nxt.z * g.zsB + (size_t)nxt.pn * tstep : cB;
        for (int t = 0; t < nt; t += 2) {
            const bool last = (t == nt - 2);
            const char* a1 = cA + (size_t)(t + 1) * kstep;
            const char* a2 = last ? nA : cA + (size_t)(t + 2) * kstep; const char* b2 = last ? nB : cB + (size_t)(t + 2) * kstep;
            const char* a3 = a2 + kstep; const char* b3 = b2 + kstep;
            unsigned s0[2], s1[2];
            s0[0] = last ? gN[0][0] : gA[0][0]; s0[1] = last ? gN[0][1] : gA[0][1]; s1[0] = last ? gN[1][0] : gA[1][0]; s1[1] = last ? gN[1][1] : gA[1][1];
            PG8_LDB(B0, 0, 0); PG8_LDB(B1, 0, 1); PG8_SCHED; PG8_LDA(At, 0, 0); PG8_STAGE(PG8_SA(1, 1), a1 + hA, gA[1]);
            PG8_WAIT_V(8); PG8_WAIT_L(0); PG8_BAR; PG8_MMA(0, 0, At, B0); PG8_MMA(0, 1, At, B1); PG8_BAR; PG8_SCHED;
            PG8_LDA(At, 0, 1); PG8_STAGE(PG8_SB(0, 0), b2, voffB); PG8_STAGE(PG8_SB(0, 1), b2 + hstep, voffB); PG8_STAGE(PG8_SA(0, 0), a2, s0);
            PG8_WAIT_V(8); PG8_WAIT_L(0); PG8_BAR; PG8_MMA(1, 0, At, B0); PG8_MMA(1, 1, At, B1); PG8_BAR; PG8_SCHED;
            PG8_LDB(B0, 1, 0); PG8_LDB(B1, 1, 1); PG8_SCHED; PG8_LDA(At, 1, 0); PG8_STAGE(PG8_SA(0, 1), a2 + hA, s1);
            PG8_WAIT_V(8); PG8_WAIT_L(0); PG8_BAR; PG8_MMA(0, 0, At, B0); PG8_MMA(0, 1, At, B1); PG8_BAR; PG8_SCHED;
            PG8_LDA(At, 1, 1); PG8_STAGE(PG8_SB(1, 0), b3, voffB); PG8_STAGE(PG8_SB(1, 1), b3 + hstep, voffB); PG8_STAGE(PG8_SA(1, 0), a3, s0);
            PG8_WAIT_V(8); PG8_WAIT_L(0); PG8_BAR; PG8_MMA(1, 0, At, B0); PG8_MMA(1, 1, At, B1); PG8_BAR; PG8_SCHED;
        }
        if (wr == 0) PG8_BAR;
        E(acc, cur, wr, wc, fr, fq);
        if (!has_next) break;
        if (!E.keep(cur))
#pragma unroll
        for (int a = 0; a < 2; ++a)
#pragma unroll
            for (int b = 0; b < 2; ++b)
#pragma unroll
                for (int m = 0; m < 4; ++m)
#pragma unroll
                    for (int n = 0; n < 2; ++n) acc[a][b][m][n] = (f32x4){0.f, 0.f, 0.f, 0.f};
        cur = nxt; cA = nA; cB = nB; ++ui;
#pragma unroll
        for (int h = 0; h < 2; ++h) { gA[h][0] = gN[h][0]; gA[h][1] = gN[h][1]; }
        if (wr == 1) PG8_BAR;
    }
    PG8_WAIT_V(0);
    PG8_BAR;
#undef PG8_SA
#undef PG8_SB
#undef PG8_STAGE
#undef PG8_GLOAD
#undef PG8_LDA
#undef PG8_LDB
#undef PG8_MMA
#undef PG8_WAIT_V
#undef PG8_WAIT_L
#undef PG8_BAR
#undef PG8_SCHED
}
}

constexpr int SEQ = 16384, DM = 1024, NL = 4;
constexpr int NPROJ = 5120;
constexpr int C_Z = 0, C_XBC = 512, C_SBQKV = 1536, C_GQKV = 3072, C_GGATE = 4608, C_BRG = 5120;
constexpr int IN_COLS = 8208;
constexpr float EPS = 1e-6f;
constexpr int NSLOT = 40960;
constexpr int NWAVES = 8;

constexpr size_t MiB = 1u << 20;
constexpr size_t WS_CTL = 0, CTL_ZERO_BYTES = 1 * MiB;
constexpr size_t WS_MODP = 1 * MiB;
constexpr size_t WS_MODF = 1 * MiB + 896 * 1024;
constexpr size_t WS_WSM = 2 * MiB;
constexpr size_t WS_WRT = 3 * MiB;
constexpr size_t WS_PAIR = 4 * MiB;
constexpr size_t WS_TOKOF = 580 * MiB;
constexpr size_t WS_SMALL = 5 * MiB;
constexpr size_t WS_WIN = 8 * MiB;
constexpr size_t WS_WBR = 72 * MiB;
constexpr size_t WS_WOUT = 84 * MiB;
constexpr size_t WS_WGU = 92 * MiB;
constexpr size_t WS_WD = 348 * MiB;
constexpr size_t WS_HB = 476 * MiB;
constexpr size_t WS_YBR = 508 * MiB;
constexpr size_t WS_PROJ = 620 * MiB;
constexpr size_t WS_GATES = 780 * MiB;
constexpr size_t WS_ACT = 700 * MiB;
constexpr size_t WS_YP = 740 * MiB;
constexpr size_t WS_MERGED = 940 * MiB;
constexpr size_t WS_XBCB = 876 * MiB;
constexpr size_t WS_SST = 908 * MiB;
constexpr size_t WS_SHIN = 556 * MiB;
constexpr size_t WS_ACUM = 572 * MiB;
constexpr size_t WS_SDEC = 573 * MiB;
constexpr size_t WS_GQE = 588 * MiB;
constexpr size_t WS_GOU = 604 * MiB;
constexpr size_t WS_GAP = 940 * MiB;
constexpr size_t WS_GBT = 972 * MiB;
constexpr size_t WS_GST = 1004 * MiB;
constexpr size_t WS_GDEC = 7 * MiB + 512 * 1024;
constexpr size_t WS_GAP2 = 574 * MiB;
constexpr size_t WS_GBT2 = 576 * MiB;
constexpr size_t WS_GST2 = 578 * MiB;
constexpr size_t WS_END = 1036 * MiB;
constexpr int CW_TMO = 0;
constexpr int CW_BAR = 4096;
constexpr int CW_SBQ = 190000;
constexpr int CW_CNT = 200000;
constexpr int N_PHASES = 54;

constexpr int LDS_BYTES = 151552;
constexpr int MISC_OFF = 147456;

#define GAS __attribute__((address_space(1)))
#define LAS __attribute__((address_space(3)))
typedef unsigned short bf16;
typedef unsigned v4u __attribute__((ext_vector_type(4)));
typedef unsigned v2u __attribute__((ext_vector_type(2)));
typedef float f32x4 __attribute__((ext_vector_type(4)));
typedef float f32x2 __attribute__((ext_vector_type(2)));
__device__ __forceinline__ unsigned f2bf(float f) { unsigned u = __builtin_bit_cast(unsigned, f); return (u + 0x7fffu + ((u >> 16) & 1u)) >> 16; }
__device__ __forceinline__ unsigned pk2(float lo, float hi) { return f2bf(lo) | (f2bf(hi) << 16); }
__device__ __forceinline__ float bflo(unsigned u) { return __uint_as_float(u << 16); }
__device__ __forceinline__ float bfhi(unsigned u) { return __uint_as_float(u & 0xffff0000u); }
__device__ __forceinline__ void unpack8(const v4u u, float* f) { f[0] = bflo(u.x); f[1] = bfhi(u.x); f[2] = bflo(u.y); f[3] = bfhi(u.y); f[4] = bflo(u.z); f[5] = bfhi(u.z); f[6] = bflo(u.w); f[7] = bfhi(u.w); }
__device__ __forceinline__ float silu_f(float x) { return x * __builtin_amdgcn_rcpf(1.0f + __expf(-x)); }
__device__ __forceinline__ float sigmoid_f(float x) { return __builtin_amdgcn_rcpf(1.0f + __expf(-x)); }
__device__ __forceinline__ float softplus_f(float x) { return fmaxf(x, 0.f) + log1pf(__expf(-fabsf(x))); }
__device__ __forceinline__ float wave_sum(float v) {
#pragma unroll
    for (int o = 1; o < 64; o <<= 1) v += __shfl_xor(v, o);
    return v;
}

#define XB_TMO      128
#define XB_XCNT(j)  (256  + 64 * (j))
#define XB_XSUB(j)  (1280 + 64 * (j))
#define XB_XGEN(j)  (2304 + 64 * (j))
#define XB_TOP      3328
#define XB_TOPGEN   3392
#define XCD_BAR_WORDS 3456
#define XB_SPIN_CAP (1u << 18)
__device__ __forceinline__ unsigned xb_ld(unsigned* p)              { return __hip_atomic_load(p, __ATOMIC_RELAXED, __HIP_MEMORY_SCOPE_AGENT); }
__device__ __forceinline__ unsigned xb_add(unsigned* p, unsigned v) { return __hip_atomic_fetch_add(p, v, __ATOMIC_RELAXED, __HIP_MEMORY_SCOPE_AGENT); }
__device__ __forceinline__ unsigned xb_xcc_id() { return (unsigned)__builtin_amdgcn_s_getreg((3 << 11) | 20) & 0xFu; }
#define XB_SPIN(cond, bar) do { unsigned _sp = 0; while (cond) { __builtin_amdgcn_s_sleep(1); \
    if ((++_sp & 255u) == 0u) { if (xb_ld(&(bar)[XB_TMO])) break; if (_sp > XB_SPIN_CAP) { atomicAdd(&(bar)[XB_TMO], 1u); break; } } } } while (0)
struct XcdBarrier { unsigned* bar; unsigned x; volatile LAS unsigned* st; };
__device__ __forceinline__ XcdBarrier xcd_barrier_post(unsigned* bar, volatile LAS unsigned* st) {
    XcdBarrier b; b.bar = bar; b.x = xb_xcc_id(); b.st = st;
    if (threadIdx.x == 0) (void)xb_add(&bar[XB_XCNT(b.x)], 1u);
    return b;
}
__device__ __forceinline__ void xcd_barrier_complete(unsigned* bar, unsigned x, unsigned& nloc, unsigned& nx) {
    const unsigned G = gridDim.x * gridDim.y * gridDim.z;
    unsigned sum, cnt, mine, sp = 0u;
    for (;;) {
        sum = 0u; cnt = 0u; mine = 0u;
#pragma unroll
        for (unsigned j = 0; j < 16; ++j) { const unsigned c = xb_ld(&bar[XB_XCNT(j)]); sum += c; cnt += (c > 0u) ? 1u : 0u; mine = (j == x) ? c : mine; }
        if (sum == G) break;
        __builtin_amdgcn_s_sleep(1);
        if ((++sp & 255u) == 0u) { if (xb_ld(&bar[XB_TMO])) break; if (sp > XB_SPIN_CAP) { atomicAdd(&bar[XB_TMO], 1u); break; } }
    }
    nloc = mine > 0u ? mine : 1u; nx = cnt > 0u ? cnt : 1u;
}
__device__ __forceinline__ void xcd_barrier(const XcdBarrier& b) {
    asm volatile("s_waitcnt vmcnt(0)" ::: "memory");
    __syncthreads();
    if (threadIdx.x == 0) {
        unsigned* bar = b.bar;
        __builtin_amdgcn_s_waitcnt(0);
        unsigned nloc = b.st[0], nx = b.st[1];
        if (nloc == 0u) { xcd_barrier_complete(bar, b.x, nloc, nx); b.st[0] = nloc; b.st[1] = nx; }
        const unsigned old = xb_add(&bar[XB_XSUB(b.x)], 1u);
        const unsigned gen = old / nloc;
        if (old + 1u == (gen + 1u) * nloc) {
            __builtin_amdgcn_fence(__ATOMIC_RELEASE, "agent");
            asm volatile("s_waitcnt vmcnt(0)" ::: "memory");
            const unsigned og = xb_add(&bar[XB_TOP], 1u);
            const unsigned tg = og / nx;
            if (og + 1u == (tg + 1u) * nx) xb_add(&bar[XB_TOPGEN], 1u);
            else XB_SPIN(xb_ld(&bar[XB_TOPGEN]) == tg, bar);
            __builtin_amdgcn_fence(__ATOMIC_ACQUIRE, "agent");
            xb_add(&bar[XB_XGEN(b.x)], 1u);
            asm volatile("s_waitcnt vmcnt(0)" ::: "memory");
        } else {
            XB_SPIN(xb_ld(&bar[XB_XGEN(b.x)]) == gen, bar);
            __builtin_amdgcn_fence(__ATOMIC_ACQUIRE, "agent");
            asm volatile("s_waitcnt vmcnt(0)" ::: "memory");
        }
    }
    __syncthreads();
}

struct Frame {
    LAS unsigned char* lds;
    unsigned* ctl;
    int tid, lane, wave, vcu, G;
    const float* const* in;
    float* out;
    unsigned char* ws;
};
#define P_x F.in[0]
#define P_c F.in[1]
#define P_w_ada F.in[2]
#define P_b_ada F.in[3]
#define P_norm_mix F.in[4]
#define P_norm_ffn F.in[5]
#define P_w_in F.in[6]
#define P_ssm_conv_w F.in[7]
#define P_ssm_conv_b F.in[8]
#define P_ssm_dt_bias F.in[9]
#define P_ssm_a_log F.in[10]
#define P_ssm_d F.in[11]
#define P_ssm_norm F.in[12]
#define P_sb_q_norm F.in[13]
#define P_sb_k_norm F.in[14]
#define P_gdn_conv_w F.in[15]
#define P_gdn_a_log F.in[16]
#define P_gdn_dt_bias F.in[17]
#define P_gdn_norm F.in[18]
#define P_w_branch F.in[19]
#define P_w_out F.in[20]
#define P_w_group F.in[21]
#define P_b_group F.in[22]
#define P_w_router F.in[23]
#define P_b_router F.in[24]
#define P_w_gate F.in[25]
#define P_w_up F.in[26]
#define P_w_down F.in[27]
#define W_MODP ((float*)(F.ws + WS_MODP))
#define W_MODF ((float*)(F.ws + WS_MODF))
#define W_WSM ((float*)(F.ws + WS_WSM))
#define W_WRT ((float*)(F.ws + WS_WRT))
#define W_SMALL ((float*)(F.ws + WS_SMALL))
#define W_TOKOF ((int*)(F.ws + WS_TOKOF))
#define W_PAIRE ((int*)(F.ws + WS_PAIR))
#define W_PAIRS ((int*)(F.ws + WS_PAIR + 131072))
#define W_PAIRW ((float*)(F.ws + WS_PAIR + 262144))
#define W_WIN ((bf16*)(F.ws + WS_WIN))
#define W_WBR ((bf16*)(F.ws + WS_WBR))
#define W_WOUT ((bf16*)(F.ws + WS_WOUT))
#define W_WGU ((bf16*)(F.ws + WS_WGU))
#define W_WD ((bf16*)(F.ws + WS_WD))
#define W_HB ((bf16*)(F.ws + WS_HB))
#define W_YBR ((bf16*)(F.ws + WS_YBR))
#define W_PROJ ((bf16*)(F.ws + WS_PROJ))
#define W_GATES ((bf16*)(F.ws + WS_GATES))
#define W_ACT ((bf16*)(F.ws + WS_ACT))
#define W_YP ((bf16*)(F.ws + WS_YP))
#define W_MERGED ((bf16*)(F.ws + WS_MERGED))
#define W_XBCB ((bf16*)(F.ws + WS_XBCB))
#define W_SST ((float*)(F.ws + WS_SST))
#define W_SHIN ((bf16*)(F.ws + WS_SHIN))
#define W_ACUM ((float*)(F.ws + WS_ACUM))
#define W_SDEC ((float*)(F.ws + WS_SDEC))
#define W_GQE ((bf16*)(F.ws + WS_GQE))
#define W_GOU ((bf16*)(F.ws + WS_GOU))
#define W_GAP ((bf16*)(F.ws + WS_GAP))
#define W_GBT ((bf16*)(F.ws + WS_GBT))
#define W_GST ((bf16*)(F.ws + WS_GST))
#define W_GDEC ((float*)(F.ws + WS_GDEC))
#define W_GAP2 ((bf16*)(F.ws + WS_GAP2))
#define W_GBT2 ((bf16*)(F.ws + WS_GBT2))
#define W_GST2 ((bf16*)(F.ws + WS_GST2))


template <bool FIN>
__device__ __forceinline__ f32x4 modv4(const Frame& F, int l, int seg, int col) {
    const int o = l * 6144 + seg * 1024 + col;
    f32x4 a;
    if (FIN) a = *(const f32x4*)(W_MODF + o);
    else { a = *(const f32x4*)(P_b_ada + o);
#pragma unroll
        for (int k = 0; k < 8; ++k) a += *(const f32x4*)(W_MODP + (size_t)k * 24576 + o); }
    asm volatile("" : "+v"(a) :: "memory");
    return a;
}

__device__ __forceinline__ void transpose_item(const float* W, int ldw, bf16* WT, int ldt, int k0, LAS float* scr, int lane) {
    float tv[32];
#pragma unroll
    for (int i = 0; i < 32; ++i) tv[i] = W[(size_t)(k0 + 2 * i + (lane >> 5)) * ldw + (lane & 31)];
#pragma unroll
    for (int i = 0; i < 32; ++i) scr[(2 * i + (lane >> 5)) * 33 + (lane & 31)] = tv[i];
    asm volatile("s_waitcnt lgkmcnt(0)" ::: "memory");
    const int c = lane & 7;
#pragma unroll
    for (int j = 0; j < 4; ++j) { const int n = (lane >> 3) + 8 * j; const LAS float* s = scr + (8 * c) * 33 + n;
        v4u o; o.x = pk2(s[0 * 33], s[1 * 33]); o.y = pk2(s[2 * 33], s[3 * 33]); o.z = pk2(s[4 * 33], s[5 * 33]); o.w = pk2(s[6 * 33], s[7 * 33]);
        *(v4u*)(WT + (size_t)n * ldt + k0 + 8 * c) = o; }
    asm volatile("s_waitcnt lgkmcnt(0)" ::: "memory");
}
__device__ __forceinline__ void p0_prologue(Frame& F) {
    LAS float* scr = (LAS float*)(F.lds + F.wave * 16384);
    const int gw = F.vcu * NWAVES + F.wave, NGW = F.G * NWAVES, lane = F.lane;
    constexpr int N_MOD = 768, N_WIN = 16384, N_BR = 3072, N_OUT = 2048, N_GU = 65536, N_DN = 32768;
    for (int it = gw; it < N_MOD + N_WIN + N_BR + N_OUT + N_GU + N_DN; it += NGW) {
        int r = it;
        if (r < N_MOD) {
            const int l = r / 192, rr = r % 192, cg = rr >> 3, kc = rr & 7, col = cg * 256 + 4 * lane;
            const float* w = P_w_ada + ((size_t)l * 1024 + kc * 128) * 6144 + col; f32x4 acc = (f32x4){0.f, 0.f, 0.f, 0.f};
#pragma unroll 8
            for (int k = 0; k < 128; ++k) { const float cv = P_c[kc * 128 + k]; acc += silu_f(cv) * *(const f32x4*)(w + (size_t)k * 6144); }
            *(f32x4*)(W_MODP + (size_t)kc * 24576 + l * 6144 + col) = acc; continue; }
        r -= N_MOD;
        if (r < N_WIN) { const int l = r >> 12, q = r & 4095, kb = q >> 8, nb = q & 255, n0 = 32 * nb, sh = n0 < 1536 ? 0 : (n0 < 4608 ? 8 : 16);
            transpose_item(P_w_in + (size_t)l * 1024 * IN_COLS + n0 + sh, IN_COLS, W_WIN + ((size_t)l * 8192 + n0) * 1024, 1024, 64 * kb, scr, lane); continue; }
        r -= N_WIN;
        if (r < N_BR) { const int idx = r >> 8, q = r & 255, kb = q >> 5, nb = q & 31;
            transpose_item(P_w_branch + (size_t)idx * 512 * 1024 + 32 * nb, 1024, W_WBR + ((size_t)idx * 1024 + 32 * nb) * 512, 512, 64 * kb, scr, lane); continue; }
        r -= N_BR;
        if (r < N_OUT) { const int l = r >> 9, q = r & 511, kb = q >> 5, nb = q & 31;
            transpose_item(P_w_out + (size_t)l * 1024 * 1024 + 32 * nb, 1024, W_WOUT + ((size_t)l * 1024 + 32 * nb) * 1024, 1024, 64 * kb, scr, lane); continue; }
        r -= N_OUT;
        if (r < N_GU) { const int idx = r >> 8, le = idx >> 1, up = idx & 1, q = r & 255, kb = q >> 4, nb = q & 15, n0 = 32 * nb, drow = (n0 >> 7) * 256 + (n0 & 127) + up * 128;
            transpose_item((up ? P_w_up : P_w_gate) + (size_t)le * 1024 * 512 + n0, 512, W_WGU + ((size_t)le * 1024 + drow) * 1024, 1024, 64 * kb, scr, lane); continue; }
        r -= N_GU;
        { const int le = r >> 8, q = r & 255, kb = q >> 5, nb = q & 31;
            transpose_item(P_w_down + (size_t)le * 512 * 1024 + 32 * nb, 1024, W_WD + ((size_t)le * 1024 + 32 * nb) * 512, 512, 64 * kb, scr, lane); }
    }
    const int gt = F.vcu * 512 + F.tid, NGT = F.G * 512;
    for (int i = gt; i < NL * 16 * 1024; i += NGT) { const int l = i >> 14, j = (i >> 10) & 15, k = i & 1023; const int oc = j < 8 ? 1536 + j : 4616 + (j - 8);
        W_WSM[i] = P_w_in[((size_t)l * 1024 + k) * IN_COLS + oc]; }
    for (int i = gt; i < NL * 36 * 1024; i += NGT) { const int l = i / 36864, q = i % 36864, j = q >> 10, k = q & 1023;
        W_WRT[i] = j < 4 ? P_w_group[((size_t)l * 1024 + k) * 4 + j] : P_w_router[((size_t)l * 1024 + k) * 32 + (j - 4)]; }
}

__device__ __forceinline__ int build_tile_table(Frame& F, int l, LAS int* tab) {
    __syncthreads();
    if (F.tid < 64) {
        const unsigned cnt = F.tid < 32 ? __hip_atomic_load(F.ctl + CW_CNT + (l * 32 + (F.tid & 31)) * 64, __ATOMIC_RELAXED, __HIP_MEMORY_SCOPE_AGENT) : 0u;
        int nt = (int)((cnt + 255u) >> 8), inc = nt;
#pragma unroll
        for (int o = 1; o < 32; o <<= 1) { const int v = __shfl_up(inc, o); if (F.lane >= o) inc += v; }
        if (F.tid < 32) { tab[F.tid] = inc - nt; tab[64 + F.tid] = (int)cnt; }
        if (F.tid == 31) tab[32] = inc; }
    __syncthreads();
    return tab[32];
}

#define TR_STEP(HALF, OFF) { const bool hi_ = (lane & (OFF)) != 0; _Pragma("unroll") for (int i_ = 0; i_ < (HALF); ++i_) { \
        const float snd_ = hi_ ? v[i_] : v[(HALF) + i_]; const float kp_ = hi_ ? v[(HALF) + i_] : v[i_]; v[i_] = kp_ + __shfl_xor(snd_, (OFF)); } }
__device__ __forceinline__ float treduce16(float (&v)[16], int lane) { TR_STEP(8, 32) TR_STEP(4, 16) TR_STEP(2, 8) TR_STEP(1, 4) float r = v[0]; r += __shfl_xor(r, 2); r += __shfl_xor(r, 1); return r; }
__device__ __forceinline__ float treduce32(float (&v)[32], int lane) { TR_STEP(16, 32) TR_STEP(8, 16) TR_STEP(4, 8) TR_STEP(2, 4) TR_STEP(1, 2) float r = v[0]; r += __shfl_xor(r, 1); return r; }
__device__ __forceinline__ float treduce4(float (&v)[4], int lane) { TR_STEP(2, 32) TR_STEP(1, 16) float r = v[0]; r += __shfl_xor(r, 8); r += __shfl_xor(r, 4); r += __shfl_xor(r, 2); r += __shfl_xor(r, 1); return r; }
#undef TR_STEP
constexpr int GRPW_OFF = 131072;
template <bool FFN>
__device__ __forceinline__ void phase_norm(Frame& F, int l) {
    const int lane = F.lane, gw = F.vcu * NWAVES + F.wave, NGW = F.G * NWAVES;
    const bool comb = (!FFN) && l > 0;
    LAS float* WL = (LAS float*)F.lds; LAS float* WG = (LAS float*)(F.lds + GRPW_OFF);
    if (!FFN) { const f32x4* s = (const f32x4*)(W_WSM + (size_t)l * 16 * 1024); for (int i = F.tid; i < 4096; i += 512) ((LAS f32x4*)WL)[i] = s[i]; }
    else { const f32x4* s = (const f32x4*)(W_WRT + (size_t)l * 36 * 1024); for (int i = F.tid; i < 8192; i += 512) ((LAS f32x4*)WL)[i] = s[1024 + i];
           for (int i = F.tid; i < 1024; i += 512) ((LAS f32x4*)WG)[i] = s[i]; }
    f32x4 A4[4], B4[4], G4[4];
    const float* ng = (FFN ? P_norm_ffn : P_norm_mix) + l * 1024;
#pragma unroll
    for (int j = 0; j < 4; ++j) { const int col = j * 256 + 4 * lane; const f32x4 g = *(const f32x4*)(ng + col);
        f32x4 sh, sc;
        if (!FFN && l == 0) { sh = modv4<false>(F, l, 0, col); sc = modv4<false>(F, l, 1, col); }
        else { sh = modv4<true>(F, l, FFN ? 3 : 0, col); sc = modv4<true>(F, l, FFN ? 4 : 1, col); }
        A4[j] = g * (sc + 1.0f); B4[j] = sh; G4[j] = comb ? modv4<true>(F, l - 1, 5, col) : (f32x4){0.f, 0.f, 0.f, 0.f}; }
    const float* xin = (!FFN && l == 0) ? P_x : F.out;
    LAS int* ttab = (LAS int*)(F.lds + MISC_OFF + 3072);
    if (comb) build_tile_table(F, l - 1, ttab);
    float be = 0.f, bg = 0.f;
    LAS int* lcnt = (LAS int*)(F.lds + MISC_OFF + 2048); LAS int* lbase = lcnt + 32;
    if (FFN) { be = P_b_router[l * 32 + ((lane >> 1) & 31)]; bg = P_b_group[l * 4 + ((lane >> 4) & 3)]; if (F.tid < 32) lcnt[F.tid] = 0; }
    __syncthreads();
    for (int m0 = 2 * gw; m0 < SEQ; m0 += 2 * NGW) {
        f32x4 v[2][4];
#pragma unroll
        for (int r = 0; r < 2; ++r)
#pragma unroll
            for (int j = 0; j < 4; ++j) v[r][j] = ((const f32x4*)(xin + (size_t)(m0 + r) * 1024))[64 * j + lane];
        if (comb) {
#pragma unroll
            for (int r = 0; r < 2; ++r) { const int m = m0 + r;
                const int s0 = ttab[W_PAIRE[2 * m]] * 256 + W_PAIRS[2 * m], s1 = ttab[W_PAIRE[2 * m + 1]] * 256 + W_PAIRS[2 * m + 1]; const float w0 = W_PAIRW[2 * m], w1 = W_PAIRW[2 * m + 1];
                const v2u* y0 = (const v2u*)(W_YP + (size_t)s0 * 1024); const v2u* y1 = (const v2u*)(W_YP + (size_t)s1 * 1024);
#pragma unroll
                for (int j = 0; j < 4; ++j) { const v2u a = y0[64 * j + lane], b = y1[64 * j + lane];
                    f32x4 y; y[0] = w0 * bflo(a.x) + w1 * bflo(b.x); y[1] = w0 * bfhi(a.x) + w1 * bfhi(b.x); y[2] = w0 * bflo(a.y) + w1 * bflo(b.y); y[3] = w0 * bfhi(a.y) + w1 * bfhi(b.y);
                    v[r][j] += G4[j] * y; ((f32x4*)(F.out + (size_t)m * 1024))[64 * j + lane] = v[r][j]; } }
        }
        float ss[2];
#pragma unroll
        for (int r = 0; r < 2; ++r) { float s = 0.f;
#pragma unroll
            for (int j = 0; j < 4; ++j) s += (v[r][j][0] * v[r][j][0] + v[r][j][1] * v[r][j][1]) + (v[r][j][2] * v[r][j][2] + v[r][j][3] * v[r][j][3]);
            ss[r] = s; }
#pragma unroll
        for (int o = 1; o < 64; o <<= 1) { ss[0] += __shfl_xor(ss[0], o); ss[1] += __shfl_xor(ss[1], o); }
#pragma unroll
        for (int r = 0; r < 2; ++r) { const float rstd = rsqrtf(ss[r] * (1.0f / 1024.0f) + EPS);
#pragma unroll
            for (int j = 0; j < 4; ++j) { v[r][j] = v[r][j] * rstd * A4[j] + B4[j];
                v2u o; o.x = pk2(v[r][j][0], v[r][j][1]); o.y = pk2(v[r][j][2], v[r][j][3]); ((v2u*)(W_HB + (size_t)(m0 + r) * 1024))[64 * j + lane] = o; } }
        if (!FFN) {
            float a0[16], a1[16]; const LAS float* wl = WL + 4 * lane; asm volatile("" : "+v"(wl));
#pragma unroll
            for (int c = 0; c < 16; ++c) { f32x2 q0 = (f32x2){0.f, 0.f}, q1 = (f32x2){0.f, 0.f};
#pragma unroll
                for (int j = 0; j < 4; ++j) { const f32x4 w = *(const LAS f32x4*)(wl + c * 1024 + j * 256);
                    const f32x2 wa = (f32x2){w[0], w[1]}, wb = (f32x2){w[2], w[3]};
                    q0 += (f32x2){v[0][j][0], v[0][j][1]} * wa; q0 += (f32x2){v[0][j][2], v[0][j][3]} * wb; q1 += (f32x2){v[1][j][0], v[1][j][1]} * wa; q1 += (f32x2){v[1][j][2], v[1][j][3]} * wb; }
                a0[c] = q0.x + q0.y; a1[c] = q1.x + q1.y; if ((c & 7) == 7) asm volatile("" ::: "memory"); }
            const float r0 = treduce16(a0, lane), r1 = treduce16(a1, lane);
            if ((lane & 3) == 0) { W_SMALL[(size_t)m0 * 16 + (lane >> 2)] = r0; W_SMALL[(size_t)(m0 + 1) * 16 + (lane >> 2)] = r1; }
        } else {
            float e0[32], e1[32], g0[4], g1[4];
            const LAS float* wlo = WL + 4 * lane; const LAS float* whi = WL + 16384 + 4 * lane; const LAS float* wgl = WG + 4 * lane; asm volatile("" : "+v"(wlo), "+v"(whi), "+v"(wgl));
#pragma unroll
            for (int c = 0; c < 32; ++c) { f32x2 q0 = (f32x2){0.f, 0.f}, q1 = (f32x2){0.f, 0.f};
#pragma unroll
                for (int j = 0; j < 4; ++j) { const f32x4 w = *(const LAS f32x4*)((c < 16 ? wlo : whi) + (c & 15) * 1024 + j * 256);
                    const f32x2 wa = (f32x2){w[0], w[1]}, wb = (f32x2){w[2], w[3]};
                    q0 += (f32x2){v[0][j][0], v[0][j][1]} * wa; q0 += (f32x2){v[0][j][2], v[0][j][3]} * wb; q1 += (f32x2){v[1][j][0], v[1][j][1]} * wa; q1 += (f32x2){v[1][j][2], v[1][j][3]} * wb; }
                e0[c] = q0.x + q0.y; e1[c] = q1.x + q1.y; if ((c & 7) == 7) asm volatile("" ::: "memory"); }
#pragma unroll
            for (int c = 0; c < 4; ++c) { f32x2 q0 = (f32x2){0.f, 0.f}, q1 = (f32x2){0.f, 0.f};
#pragma unroll
                for (int j = 0; j < 4; ++j) { const f32x4 w = *(const LAS f32x4*)(wgl + c * 1024 + j * 256);
                    const f32x2 wa = (f32x2){w[0], w[1]}, wb = (f32x2){w[2], w[3]};
                    q0 += (f32x2){v[0][j][0], v[0][j][1]} * wa; q0 += (f32x2){v[0][j][2], v[0][j][3]} * wb; q1 += (f32x2){v[1][j][0], v[1][j][1]} * wa; q1 += (f32x2){v[1][j][2], v[1][j][3]} * wb; }
                g0[c] = q0.x + q0.y; g1[c] = q1.x + q1.y; }
            float xe[2], xg[2];
            xe[0] = treduce32(e0, lane) + be; xe[1] = treduce32(e1, lane) + be; xg[0] = treduce4(g0, lane) + bg; xg[1] = treduce4(g1, lane) + bg;
#pragma unroll
            for (int r = 0; r < 2; ++r) { const int m = m0 + r;
                float lgr[4];
#pragma unroll
                for (int c = 0; c < 4; ++c) lgr[c] = __shfl(xg[r], c << 4);
                int gs = 0; float gm = lgr[0];
#pragma unroll
                for (int c = 1; c < 4; ++c) if (lgr[c] > gm) { gm = lgr[c]; gs = c; }
                float den = 0.f;
#pragma unroll
                for (int c = 0; c < 4; ++c) den += __expf(lgr[c] - gm);
                const float pg = 1.0f / den;
                float lr[8];
#pragma unroll
                for (int i = 0; i < 8; ++i) lr[i] = __shfl(xe[r], (8 * gs + i) << 1);
                int i1 = 0; float m1 = lr[0];
#pragma unroll
                for (int i = 1; i < 8; ++i) if (lr[i] > m1) { m1 = lr[i]; i1 = i; }
                int i2 = -1; float m2 = -3.0e38f;
#pragma unroll
                for (int i = 0; i < 8; ++i) if (i != i1 && lr[i] > m2) { m2 = lr[i]; i2 = i; }
                const float t = __expf(m2 - m1), w1 = pg / (1.0f + t), w2 = pg * t / (1.0f + t);
                if (lane == 0) {
                    const int e1i = gs * 8 + i1, e2i = gs * 8 + i2;
                    const int p1 = __hip_atomic_fetch_add(lcnt + e1i, 1, __ATOMIC_RELAXED, __HIP_MEMORY_SCOPE_WORKGROUP), p2 = __hip_atomic_fetch_add(lcnt + e2i, 1, __ATOMIC_RELAXED, __HIP_MEMORY_SCOPE_WORKGROUP);
                    W_PAIRE[2 * m] = e1i; W_PAIRE[2 * m + 1] = e2i; W_PAIRS[2 * m] = (int)p1; W_PAIRS[2 * m + 1] = (int)p2; W_PAIRW[2 * m] = w1; W_PAIRW[2 * m + 1] = w2;
                } }
        }
    }
    if (FFN) {
        asm volatile("s_waitcnt vmcnt(0)" ::: "memory");
        __syncthreads();
        if (F.tid < 32) { const int c = lcnt[F.tid]; lbase[F.tid] = c ? (int)atomicAdd(F.ctl + CW_CNT + (l * 32 + F.tid) * 64, (unsigned)c) : 0; }
        __syncthreads();
        for (int m0 = 2 * gw; m0 < SEQ; m0 += 2 * NGW) if (lane < 4) { const int idx = 2 * m0 + lane, e = W_PAIRE[idx], pos = W_PAIRS[idx] + lbase[e];
            W_PAIRS[idx] = pos; W_TOKOF[e * 16384 + pos] = m0 + (lane >> 1); }
    }
    if (!FFN && l == 0) {
        for (int i = F.vcu * 512 + F.tid; i < NL * 6144; i += F.G * 512) { float a = P_b_ada[i];
#pragma unroll
            for (int k = 0; k < 8; ++k) a += W_MODP[(size_t)k * 24576 + i];
            W_MODF[i] = a; }
    }
    __syncthreads();
}


typedef short bf16x8 __attribute__((ext_vector_type(8)));
#define MFMA16(a, b, c) __builtin_amdgcn_mfma_f32_16x16x32_bf16(a, b, c, 0, 0, 0)
constexpr int GX_KN = 0, GX_QN = 17408, GX_LM = 34816, GX_MX = 62464, GX_TRT = 79872, GX_SC = 116736;

__device__ __forceinline__ void gdn_phase_x(Frame& F, int l) {
    LAS unsigned char* L = F.lds;
    LAS bf16* Kn = (LAS bf16*)(L + GX_KN);
    LAS bf16* Qn = (LAS bf16*)(L + GX_QN);
    LAS bf16* LM = (LAS bf16*)(L + GX_LM);
    LAS float* Mx = (LAS float*)(L + GX_MX);
    LAS bf16* TRT = (LAS bf16*)(L + GX_TRT);
    const int tid = F.tid, lane = F.lane, w = F.wave, r16 = lane & 15, kq = lane >> 4;
    const float* cw = P_gdn_conv_w + (size_t)l * 4 * 1536;
    LAS float* SC = (LAS float*)(L + GX_SC);
    for (int k = w; F.vcu + k * F.G < 1024; k += NWAVES) { const int u = F.vcu + k * F.G, hh = u >> 8, t0 = (u & 255) * 64; LAS float* s = SC + k * 320;
        float g = -__expf(P_gdn_a_log[l * 4 + hh]) * softplus_f(W_SMALL[(size_t)(t0 + lane) * 16 + 8 + hh] + P_gdn_dt_bias[l * 4 + hh]);
#pragma unroll
        for (int o = 1; o < 64; o <<= 1) { const float v = __shfl_up(g, o); if (lane >= o) g += v; }
        const float gl = __shfl(g, 63), b = sigmoid_f(W_SMALL[(size_t)(t0 + lane) * 16 + 12 + hh]), ga = __expf(g);
        s[lane] = g; s[64 + lane] = b; s[128 + lane] = ga; s[192 + lane] = __expf(gl - g); s[256 + lane] = b * ga;
        if (lane == 63) W_GDEC[u] = ga; }
    v4u xr[3][4][2];
#define GX_LOADX(uu, S0, S1) do { const int hh_ = (uu) >> 8, t0_ = ((uu) & 255) * 64, t_ = tid >> 3, c8_ = tid & 7; _Pragma("unroll") for (int sg_ = (S0); sg_ < (S1); ++sg_) _Pragma("unroll") for (int i_ = 0; i_ < 4; ++i_) { \
        const int ts_ = t0_ + t_ - 3 + i_; const bf16* xp_ = W_PROJ + (size_t)(ts_ < 0 ? 0 : ts_) * NPROJ + C_GQKV + sg_ * 512 + hh_ * 128 + 16 * c8_; xr[sg_][i_][0] = *(const v4u*)xp_; xr[sg_][i_][1] = *(const v4u*)(xp_ + 8); } } while (0)
    if (F.vcu < 1024) GX_LOADX(F.vcu, 0, 2);
    __syncthreads();
    int kun = 0;
    const int tid_outer = tid;
    for (int u = F.vcu; u < 1024; u += F.G, ++kun) {
        int tid_l = tid_outer; asm volatile("" : "+v"(tid_l));
        const int tid = tid_l, lane = tid & 63, r16 = lane & 15, kq = lane >> 4;
        const int hh = u >> 8, ch = u & 255, t0 = ch * 64;
        LAS float* gc = SC + kun * 320; LAS float* be = gc + 64; LAS float* gam = be + 64; LAS float* kdec = gam + 64; LAS float* bg = kdec + 64;
        { const int t = tid >> 3, c8 = tid & 7;
          GX_LOADX(u, 2, 3);
#pragma unroll
          for (int sg = 0; sg < 3; ++sg) { const int cb = sg * 512 + hh * 128 + 16 * c8; float a[16];
#pragma unroll
            for (int e = 0; e < 16; ++e) a[e] = 0.f;
#pragma unroll
            for (int i = 0; i < 4; ++i) { const int ts = t0 + t - 3 + i; const float msk = ts < 0 ? 0.f : 1.f; float xv[16]; unpack8(xr[sg][i][0], xv); unpack8(xr[sg][i][1], xv + 8);
#pragma unroll
                for (int e4 = 0; e4 < 4; ++e4) { const f32x4 wv = *(const f32x4*)(cw + i * 1536 + cb + 4 * e4) * msk;
                    a[4 * e4] += wv[0] * xv[4 * e4]; a[4 * e4 + 1] += wv[1] * xv[4 * e4 + 1]; a[4 * e4 + 2] += wv[2] * xv[4 * e4 + 2]; a[4 * e4 + 3] += wv[3] * xv[4 * e4 + 3]; } }
            float ss = 0.f;
#pragma unroll
            for (int e = 0; e < 16; ++e) { a[e] = silu_f(a[e]); ss += a[e] * a[e]; }
            if (sg < 2) { ss += __shfl_xor(ss, 1); ss += __shfl_xor(ss, 2); ss += __shfl_xor(ss, 4); const float sc = rsqrtf(ss + EPS) * (sg == 0 ? 0.08838834764831845f : 1.0f);
#pragma unroll
                for (int e = 0; e < 16; ++e) a[e] *= sc; }
            if (sg == 0) { v4u o0, o1; o0.x = pk2(a[0], a[1]); o0.y = pk2(a[2], a[3]); o0.z = pk2(a[4], a[5]); o0.w = pk2(a[6], a[7]); o1.x = pk2(a[8], a[9]); o1.y = pk2(a[10], a[11]); o1.z = pk2(a[12], a[13]); o1.w = pk2(a[14], a[15]);
                *(LAS v4u*)(Qn + t * 136 + 16 * c8) = o0; *(LAS v4u*)(Qn + t * 136 + 16 * c8 + 8) = o1; }
            else if (sg == 1) { v4u o0, o1; o0.x = pk2(a[0], a[1]); o0.y = pk2(a[2], a[3]); o0.z = pk2(a[4], a[5]); o0.w = pk2(a[6], a[7]); o1.x = pk2(a[8], a[9]); o1.y = pk2(a[10], a[11]); o1.z = pk2(a[12], a[13]); o1.w = pk2(a[14], a[15]);
                *(LAS v4u*)(Kn + t * 136 + 16 * c8) = o0; *(LAS v4u*)(Kn + t * 136 + 16 * c8 + 8) = o1;
                const float kd = kdec[t], bgt = bg[t];
#pragma unroll
                for (int e = 0; e < 16; ++e) { LM[(16 * c8 + e) * 72 + t] = (bf16)f2bf(a[e] * kd); TRT[(16 * c8 + e) * 72 + t] = (bf16)f2bf(a[e] * bgt); } }
            else { const float bt = be[t];
#pragma unroll
                for (int e = 0; e < 16; ++e) TRT[(128 + 16 * c8 + e) * 72 + t] = (bf16)f2bf(a[e] * bt); }
            asm volatile("" ::: "memory"); } }
        __syncthreads();
        { const LAS bf16* Ab = (w < 4 ? Kn : Qn) + (16 * (w & 3) + r16) * 136 + 8 * kq; bf16x8 a[4];
#pragma unroll
          for (int ks = 0; ks < 4; ++ks) a[ks] = *(const LAS bf16x8*)(Ab + 32 * ks);
#pragma unroll
          for (int nt = 0; nt < 4; ++nt) { f32x4 d = (f32x4){0.f, 0.f, 0.f, 0.f};
#pragma unroll
            for (int ks = 0; ks < 4; ++ks) { const bf16x8 b = *(const LAS bf16x8*)(Kn + (16 * nt + r16) * 136 + 32 * ks + 8 * kq); d = MFMA16(a[ks], b, d); }
            const int jt = 16 * nt + r16; const float gj = gc[jt];
#pragma unroll
            for (int j = 0; j < 4; ++j) { const int i = 16 * (w & 3) + 4 * kq + j; const float e = __expf(gc[i] - gj);
                if (w < 4) Mx[jt * 68 + i] = (jt < i) ? be[i] * d[j] * e : 0.f;
                else LM[(128 + i) * 72 + jt] = (bf16)f2bf((jt <= i) ? d[j] * e : 0.f); } } }
        __syncthreads();
        if (u + F.G < 1024) GX_LOADX(u + F.G, 0, 2);
        if (w < 4) { LAS bf16* row = TRT + (64 * w + lane) * 72;
            const LAS float* Mto = Mx; asm volatile("" : "+v"(Mto));
#pragma unroll 1
            for (int rb = 0; rb < 4; ++rb) {
                float acc[16];
                unpack8(*(const LAS v4u*)(row + 16 * rb), acc); unpack8(*(const LAS v4u*)(row + 16 * rb + 8), acc + 8);
#pragma unroll 1
                for (int j8 = 0; j8 < 2 * rb; ++j8) {
                    float xv[8]; unpack8(*(const LAS v4u*)(row + 8 * j8), xv);
                    const LAS float* mp = Mto + (8 * j8) * 68 + 16 * rb;
                    f32x4 mc[2][4], mn[2][4];
#pragma unroll
                    for (int e = 0; e < 2; ++e)
#pragma unroll
                        for (int q = 0; q < 4; ++q) mc[e][q] = *(const LAS f32x4*)(mp + e * 68 + 4 * q);
#pragma unroll
                    for (int p = 0; p < 4; ++p) {
                        if (p < 3) {
#pragma unroll
                            for (int e = 0; e < 2; ++e)
#pragma unroll
                                for (int q = 0; q < 4; ++q) mn[e][q] = *(const LAS f32x4*)(mp + (2 * p + 2 + e) * 68 + 4 * q); }
                        asm volatile("" ::: "memory");
#pragma unroll
                        for (int e = 0; e < 2; ++e)
#pragma unroll
                            for (int q = 0; q < 4; ++q)
#pragma unroll
                                for (int k = 0; k < 4; ++k) acc[4 * q + k] -= mc[e][q][k] * xv[2 * p + e];
#pragma unroll
                        for (int e = 0; e < 2; ++e)
#pragma unroll
                            for (int q = 0; q < 4; ++q) mc[e][q] = mn[e][q]; } }
#pragma unroll
                for (int jj = 0; jj < 15; ++jj) { const LAS float* mp = Mto + (16 * rb + jj) * 68 + 16 * rb;
#pragma unroll
                    for (int q = (jj + 1) / 4; q < 4; ++q) { const f32x4 m = *(const LAS f32x4*)(mp + 4 * q);
#pragma unroll
                        for (int k = 0; k < 4; ++k) if (4 * q + k > jj) acc[4 * q + k] -= m[k] * acc[jj]; }
                    if (jj & 1) asm volatile("" ::: "memory"); }
                v4u o0, o1; o0.x = pk2(acc[0], acc[1]); o0.y = pk2(acc[2], acc[3]); o0.z = pk2(acc[4], acc[5]); o0.w = pk2(acc[6], acc[7]);
                o1.x = pk2(acc[8], acc[9]); o1.y = pk2(acc[10], acc[11]); o1.z = pk2(acc[12], acc[13]); o1.w = pk2(acc[14], acc[15]);
                *(LAS v4u*)(row + 16 * rb) = o0; *(LAS v4u*)(row + 16 * rb + 8) = o1; } }
        __syncthreads();
        { bf16x8 bfr[2][2];
#pragma unroll
          for (int n2 = 0; n2 < 2; ++n2)
#pragma unroll
            for (int ks = 0; ks < 2; ++ks) bfr[n2][ks] = *(const LAS bf16x8*)(TRT + (16 * (2 * w + n2) + r16) * 72 + 32 * ks + 8 * kq);
          bf16* AP = W_GAP + (size_t)u * 16384; bf16* BT = W_GBT + (size_t)u * 16384; bf16* QE = W_GQE + (size_t)u * 8192; bf16* OU = W_GOU + (size_t)u * 8192;
#pragma unroll 1
          for (int mt = 0; mt < 8; ++mt) { bf16x8 af[2];
#pragma unroll
            for (int ks = 0; ks < 2; ++ks) af[ks] = *(const LAS bf16x8*)(LM + (16 * mt + r16) * 72 + 32 * ks + 8 * kq);
#pragma unroll
            for (int n2 = 0; n2 < 2; ++n2) { const int nt = 2 * w + n2; f32x4 d = (f32x4){0.f, 0.f, 0.f, 0.f};
                if (w >= 4) {
#pragma unroll
                    for (int ks = 0; ks < 2; ++ks) d = MFMA16(af[ks], bfr[n2][ks], d);
                    v2u o; o.x = pk2(d[0], d[1]); o.y = pk2(d[2], d[3]);
                    *(v2u*)(BT + (((nt - 8) * 4 + (mt >> 1)) * 64 + lane) * 8 + 4 * (mt & 1)) = o;
                } else {
#pragma unroll
                    for (int ks = 0; ks < 2; ++ks) d = MFMA16(bfr[n2][ks], af[ks], d);
                    v2u o; o.x = pk2(-d[0], -d[1]); o.y = pk2(-d[2], -d[3]);
                    *(v2u*)(AP + (((mt * 4 + (nt >> 1)) * 64 + kq * 16 + r16) * 8 + 4 * (nt & 1))) = o; } } }
#pragma unroll 1
          for (int mt = 8; mt < 12; ++mt) { bf16x8 af[2];
#pragma unroll
            for (int ks = 0; ks < 2; ++ks) af[ks] = *(const LAS bf16x8*)(LM + (16 * mt + r16) * 72 + 32 * ks + 8 * kq);
            const int i = 16 * (mt - 8) + r16;
#pragma unroll
            for (int n2 = 0; n2 < 2; ++n2) { const int nt = 2 * w + n2; f32x4 d = (f32x4){0.f, 0.f, 0.f, 0.f};
#pragma unroll
                for (int ks = 0; ks < 2; ++ks) d = MFMA16(bfr[n2][ks], af[ks], d);
                if (w < 4) { const int dkc = 16 * nt + 4 * kq; const v2u qv = *(const LAS v2u*)(Qn + i * 136 + dkc); const float gi = gam[i];
                    v2u o; o.x = pk2(gi * bflo(qv.x) - d[0], gi * bfhi(qv.x) - d[1]); o.y = pk2(gi * bflo(qv.y) - d[2], gi * bfhi(qv.y) - d[3]);
                    *(v2u*)(QE + i * 128 + dkc) = o; }
                else { const int dv = 16 * (nt - 8) + 4 * kq; v2u o; o.x = pk2(d[0], d[1]); o.y = pk2(d[2], d[3]);
                    *(v2u*)(OU + i * 128 + dv) = o; } } } }
        __syncthreads();
    }
}

template <int LEVEL>
__device__ __forceinline__ void gdn_seg(Frame& F, int hh, int sc, int half) {
    LAS unsigned char* L = F.lds; const int tid = F.tid, lane = F.lane, w = F.wave, r16 = lane & 15, kq = lane >> 4;
    LAS float* decs = (LAS float*)(L + MISC_OFF + 1024);
    const bool compute = (LEVEL == 1) || (w < 4), storing = (LEVEL != 1) && (w < 4), hasB = (LEVEL == 1) ? (w >= 4) : (w < 4);
    const size_t u0 = LEVEL == 2 ? (size_t)hh * 16 : (size_t)hh * 256 + 16 * sc;
    const bf16* AP = (LEVEL == 2 ? W_GAP2 : W_GAP) + u0 * 16384;
    const bf16* BT = (LEVEL == 2 ? W_GBT2 : W_GBT) + u0 * 16384 + half * 8192;
    const int lt = w & 3, nt = 4 * half + lt;
    if (LEVEL != 2 && tid < 16) decs[tid] = W_GDEC[hh * 256 + 16 * sc + tid];
    f32x4 acc[8];
#pragma unroll
    for (int t = 0; t < 8; ++t) acc[t] = (f32x4){0.f, 0.f, 0.f, 0.f};
    if (LEVEL == 1 && w < 4) {
#pragma unroll
        for (int t = 0; t < 8; ++t)
#pragma unroll
            for (int j = 0; j < 4; ++j) acc[t][j] = (16 * t + 4 * kq + j == 16 * nt + r16) ? 1.0f : 0.0f; }
    if (LEVEL == 3 && compute) { const bf16* S0 = W_GST2 + ((size_t)hh * 16 + sc) * 16384 + (size_t)(16 * nt + r16) * 128 + 4 * kq;
#pragma unroll
        for (int t = 0; t < 8; ++t) { const v2u v = *(const v2u*)(S0 + 16 * t); acc[t] = (f32x4){bflo(v.x), bfhi(v.x), bflo(v.y), bfhi(v.y)}; } }
#define GS_DMA(c) do { const int c_ = (c) < 15 ? (c) : 15; LAS unsigned char* s_ = L + ((c) % 3) * 49152; _Pragma("unroll") for (int i_ = 0; i_ < 4; ++i_) \
        __builtin_amdgcn_global_load_lds((const unsigned*)(AP + (size_t)c_ * 16384 + (i_ * 8 + w) * 512 + lane * 8), (LAS unsigned*)(s_ + (i_ * 8 + w) * 1024), 16, 0, 0); \
        _Pragma("unroll") for (int i_ = 0; i_ < 2; ++i_) \
        __builtin_amdgcn_global_load_lds((const unsigned*)(BT + (size_t)c_ * 16384 + (i_ * 8 + w) * 512 + lane * 8), (LAS unsigned*)(s_ + 32768 + (i_ * 8 + w) * 1024), 16, 0, 0); } while (0)
    asm volatile("s_waitcnt vmcnt(0)" ::: "memory");
    GS_DMA(0); GS_DMA(1);
    __syncthreads();
#pragma unroll 1
    for (int i = 0; i < 16; ++i) {
        if (storing && i > 0) asm volatile("s_waitcnt vmcnt(14)" ::: "memory"); else asm volatile("s_waitcnt vmcnt(6)" ::: "memory");
        __builtin_amdgcn_s_barrier(); asm volatile("" ::: "memory");
        GS_DMA(i + 2);
        if (compute) {
            bf16x8 Sb[4]; unsigned pk_[8][2];
#pragma unroll
            for (int t = 0; t < 8; ++t) { pk_[t][0] = pg8::cvt_pk_bf16(acc[t][0], acc[t][1]); pk_[t][1] = pg8::cvt_pk_bf16(acc[t][2], acc[t][3]); }
            if (LEVEL != 1) { bf16* ST = (LEVEL == 2 ? W_GST2 + ((size_t)hh * 16 + i) * 16384 : W_GST + ((size_t)hh * 256 + 16 * sc + i) * 16384) + (size_t)(16 * nt + r16) * 128 + 4 * kq;
#pragma unroll
                for (int t = 0; t < 8; ++t) { v2u o_; o_.x = pk_[t][0]; o_.y = pk_[t][1]; *(v2u*)(ST + 16 * t) = o_; } }
#pragma unroll
            for (int s = 0; s < 4; ++s) { v4u q_; q_.x = pk_[2 * s][0]; q_.y = pk_[2 * s][1]; q_.z = pk_[2 * s + 1][0]; q_.w = pk_[2 * s + 1][1]; Sb[s] = __builtin_bit_cast(bf16x8, q_); }
            const float dc = LEVEL == 2 ? 0.f : decs[i];
#pragma unroll
            for (int t = 0; t < 8; ++t) acc[t] = acc[t] * dc;
            const LAS unsigned char* slot = L + (i % 3) * 49152 + lane * 16;
#pragma unroll
            for (int s = 0; s < 4; ++s) { bf16x8 fa[8];
#pragma unroll
                for (int t = 0; t < 8; ++t) fa[t] = *(const LAS bf16x8*)(slot + (t * 4 + s) * 1024);
#pragma unroll
                for (int t = 0; t < 8; ++t) acc[t] = MFMA16(fa[t], Sb[s], acc[t]); }
            if (hasB) {
#pragma unroll
                for (int i4 = 0; i4 < 4; ++i4) { const v4u bv = *(const LAS v4u*)(slot + 32768 + (lt * 4 + i4) * 1024);
                    acc[2 * i4][0] += bflo(bv.x); acc[2 * i4][1] += bfhi(bv.x); acc[2 * i4][2] += bflo(bv.y); acc[2 * i4][3] += bfhi(bv.y);
                    acc[2 * i4 + 1][0] += bflo(bv.z); acc[2 * i4 + 1][1] += bfhi(bv.z); acc[2 * i4 + 1][2] += bflo(bv.w); acc[2 * i4 + 1][3] += bfhi(bv.w); } }
        }
    }
    asm volatile("s_waitcnt vmcnt(0)" ::: "memory");
    if (LEVEL == 1) {
        bf16* A2 = W_GAP2 + ((size_t)hh * 16 + sc) * 16384; bf16* B2 = W_GBT2 + ((size_t)hh * 16 + sc) * 16384;
        if (w < 4) {
#pragma unroll
            for (int t = 0; t < 8; ++t)
#pragma unroll
                for (int j = 0; j < 4; ++j) A2[((t * 4 + (nt >> 1)) * 64 + (r16 >> 2) * 16 + 4 * kq + j) * 8 + 4 * (nt & 1) + (r16 & 3)] = (bf16)f2bf(acc[t][j]);
        } else {
#pragma unroll
            for (int t = 0; t < 8; ++t) { v2u o_; o_.x = pk2(acc[t][0], acc[t][1]); o_.y = pk2(acc[t][2], acc[t][3]); *(v2u*)(B2 + ((nt * 4 + (t >> 1)) * 64 + lane) * 8 + 4 * (t & 1)) = o_; } } }
    __syncthreads();
#undef GS_DMA
}

__device__ __forceinline__ void gdn_phase_z(Frame& F, int l) {
    const int lane = F.lane, r16 = lane & 15, kq = lane >> 4, gw = F.vcu * NWAVES + F.wave, NGW = F.G * NWAVES;
    for (int wu = gw; wu < 4096; wu += NGW) { const int u = wu >> 2, mt = wu & 3, hh = u >> 8, ch = u & 255, tok = ch * 64 + 16 * mt + r16;
        const bf16* QE = W_GQE + (size_t)u * 8192 + (16 * mt + r16) * 128 + 8 * kq; const bf16* ST = W_GST + (size_t)u * 16384 + r16 * 128 + 8 * kq;
        bf16x8 qf[4];
#pragma unroll
        for (int s = 0; s < 4; ++s) qf[s] = *(const bf16x8*)(QE + 32 * s);
        bf16x8 sfr[8][4]; v2u our[8];
#pragma unroll
        for (int nt = 0; nt < 8; ++nt) {
#pragma unroll
            for (int s = 0; s < 4; ++s) sfr[nt][s] = *(const bf16x8*)(ST + nt * 16 * 128 + 32 * s);
            our[nt] = *(const v2u*)(W_GOU + (size_t)u * 8192 + (16 * mt + r16) * 128 + 16 * nt + 4 * kq); }
        f32x4 o[8]; float ss = 0.f;
#pragma unroll
        for (int nt = 0; nt < 8; ++nt) { f32x4 d = (f32x4){0.f, 0.f, 0.f, 0.f};
#pragma unroll
            for (int s = 0; s < 4; ++s) d = MFMA16(sfr[nt][s], qf[s], d);
            const v2u ou = our[nt];
            d[0] += bflo(ou.x); d[1] += bfhi(ou.x); d[2] += bflo(ou.y); d[3] += bfhi(ou.y);
            ss += (d[0] * d[0] + d[1] * d[1]) + (d[2] * d[2] + d[3] * d[3]); o[nt] = d; }
        ss += __shfl_xor(ss, 16); ss += __shfl_xor(ss, 32);
        const float rs = rsqrtf(ss * (1.0f / 128.0f) + EPS);
#pragma unroll
        for (int nt = 0; nt < 8; ++nt) { const int dv = 16 * nt + 4 * kq; const f32x4 gn = *(const f32x4*)(P_gdn_norm + l * 128 + dv);
            const v2u gt = *(const v2u*)(W_PROJ + (size_t)tok * NPROJ + C_GGATE + hh * 128 + dv);
            v2u y; y.x = pk2(o[nt][0] * rs * gn[0] * silu_f(bflo(gt.x)), o[nt][1] * rs * gn[1] * silu_f(bfhi(gt.x))); y.y = pk2(o[nt][2] * rs * gn[2] * silu_f(bflo(gt.y)), o[nt][3] * rs * gn[3] * silu_f(bfhi(gt.y)));
            *(v2u*)(W_YBR + (size_t)2 * SEQ * 512 + (size_t)tok * 512 + hh * 128 + dv) = y; }
    }
}


__device__ __forceinline__ void ssd_phase_c(Frame& F, int l) {
    LAS unsigned char* L = F.lds;
    LAS bf16* BTr = (LAS bf16*)L;
    LAS bf16* XWT = (LAS bf16*)(L + 34816);
    LAS float* acum = (LAS float*)(L + 104448); LAS float* dtv = acum + 512; LAS float* wgt = dtv + 512;
    const int tid = F.tid, lane = F.lane, w = F.wave, r16 = lane & 15, kq = lane >> 4;
    const float* cw = P_ssm_conv_w + (size_t)l * 4 * 1024; const float* cb = P_ssm_conv_b + (size_t)l * 1024;
    for (int u = F.vcu; u < 256; u += F.G) { const int c = u >> 1, g = u & 1, t0 = c * 128;
        if (w < 4) { const int h = 4 * g + w; const float bias = P_ssm_dt_bias[l * 8 + h], A = -__expf(P_ssm_a_log[l * 8 + h]);
            const float d0 = softplus_f(W_SMALL[(size_t)(t0 + 2 * lane) * 16 + h] + bias), d1 = softplus_f(W_SMALL[(size_t)(t0 + 2 * lane + 1) * 16 + h] + bias);
            const float a0 = A * d0, a1 = a0 + A * d1; float inc = a1;
#pragma unroll
            for (int o = 1; o < 64; o <<= 1) { const float v = __shfl_up(inc, o); if (lane >= o) inc += v; }
            const float ex = inc - a1, c0v = ex + a0, c1v = ex + a1, al = __shfl(inc, 63);
            acum[w * 128 + 2 * lane] = c0v; acum[w * 128 + 2 * lane + 1] = c1v; dtv[w * 128 + 2 * lane] = d0; dtv[w * 128 + 2 * lane + 1] = d1;
            wgt[w * 128 + 2 * lane] = __expf(al - c0v); wgt[w * 128 + 2 * lane + 1] = __expf(al - c1v);
            W_ACUM[(size_t)(t0 + 2 * lane) * 8 + h] = c0v; W_ACUM[(size_t)(t0 + 2 * lane + 1) * 8 + h] = c1v;
            if (lane == 63) W_SDEC[c * 8 + h] = __expf(al); }
        __syncthreads();
        { const int c16 = tid & 15, tq = tid >> 4;
#pragma unroll 1
          for (int k = 0; k < 4; ++k) { const int ch0 = (k < 2 ? g * 256 + 128 * k : (k == 2 ? 512 + g * 128 : 768 + g * 128)) + 8 * c16;
            f32x4 wv[4][2]; const f32x4 b0 = *(const f32x4*)(cb + ch0), b1 = *(const f32x4*)(cb + ch0 + 4);
#pragma unroll
            for (int i = 0; i < 4; ++i) { wv[i][0] = *(const f32x4*)(cw + i * 1024 + ch0); wv[i][1] = *(const f32x4*)(cw + i * 1024 + ch0 + 4); }
            const int hl = 2 * k + (c16 >> 3), p0 = 8 * (c16 & 7);
#pragma unroll
            for (int th = 0; th < 2; ++th) {
            v4u xra[2][4];
#pragma unroll
            for (int tp = 0; tp < 2; ++tp)
#pragma unroll
                for (int i = 0; i < 4; ++i) { const int ts = t0 + tq + 32 * (2 * th + tp) - 3 + i; xra[tp][i] = *(const v4u*)(W_PROJ + (size_t)(ts < 0 ? 0 : ts) * NPROJ + C_XBC + ch0); }
#pragma unroll
            for (int tp2 = 0; tp2 < 2; ++tp2) { const int t = tq + 32 * (2 * th + tp2); v4u xr[4];
#pragma unroll
                for (int i = 0; i < 4; ++i) xr[i] = xra[tp2][i];
                float a[8] = {b0[0], b0[1], b0[2], b0[3], b1[0], b1[1], b1[2], b1[3]};
#pragma unroll
                for (int i = 0; i < 4; ++i) { const float msk = (t0 + t - 3 + i) < 0 ? 0.f : 1.f; float xv[8]; unpack8(xr[i], xv);
#pragma unroll
                    for (int e = 0; e < 4; ++e) { a[e] += wv[i][0][e] * msk * xv[e]; a[4 + e] += wv[i][1][e] * msk * xv[4 + e]; } }
                v4u o;
#pragma unroll
                for (int e = 0; e < 8; ++e) a[e] = silu_f(a[e]);
                o.x = pk2(a[0], a[1]); o.y = pk2(a[2], a[3]); o.z = pk2(a[4], a[5]); o.w = pk2(a[6], a[7]);
                *(v4u*)(W_XBCB + (size_t)(t0 + t) * 1024 + ch0) = o;
                float ar[8]; unpack8(o, ar);
                if (k < 2) { const float sc = dtv[hl * 128 + t] * wgt[hl * 128 + t];
#pragma unroll
                    for (int e = 0; e < 8; ++e) { const int row = hl * 64 + p0 + e; XWT[row * 136 + (t ^ (((row >> 3) & 15) << 3))] = (bf16)f2bf(ar[e] * sc); } }
                else if (k == 2) {
#pragma unroll
                    for (int e = 0; e < 8; ++e) { const int row = 8 * c16 + e; BTr[row * 136 + (t ^ (((row >> 3) & 15) << 3))] = (bf16)f2bf(ar[e]); } } } asm volatile("" ::: "memory"); } } }
        __syncthreads();
        { const int hl = w >> 1, h = 4 * g + hl;
#pragma unroll 1
          for (int n4 = 0; n4 < 4; ++n4) { const int nt = 4 * (w & 1) + n4; bf16x8 af[4];
#pragma unroll
            for (int ks = 0; ks < 4; ++ks) { const int row = 16 * nt + r16; af[ks] = *(const LAS bf16x8*)(BTr + row * 136 + 8 * ((4 * ks + kq) ^ ((row >> 3) & 15))); }
#pragma unroll
            for (int pt = 0; pt < 4; ++pt) { f32x4 d = (f32x4){0.f, 0.f, 0.f, 0.f};
#pragma unroll
                for (int ks = 0; ks < 4; ++ks) { const int row = hl * 64 + 16 * pt + r16; const bf16x8 bfv = *(const LAS bf16x8*)(XWT + row * 136 + 8 * ((4 * ks + kq) ^ ((row >> 3) & 15))); d = MFMA16(af[ks], bfv, d); }
                *(f32x4*)(W_SST + (((size_t)c * 8 + h) * 64 + 16 * pt + r16) * 128 + 16 * nt + 4 * kq) = d; } } }
        __syncthreads();
    }
}
__device__ __forceinline__ void ssd_scan(Frame& F) {
    const int e4 = F.vcu * 512 + F.tid, h = e4 >> 11; f32x4 hc = (f32x4){0.f, 0.f, 0.f, 0.f};
#pragma unroll 1
    for (int cb = 0; cb < 128; cb += 16) { f32x4 s[16]; float dc[16];
#pragma unroll
        for (int k = 0; k < 16; ++k) { s[k] = *(const f32x4*)(W_SST + (size_t)(cb + k) * 65536 + 4 * e4); dc[k] = W_SDEC[(cb + k) * 8 + h]; }
#pragma unroll
        for (int k = 0; k < 16; ++k) { v2u o; o.x = pk2(hc[0], hc[1]); o.y = pk2(hc[2], hc[3]); *(v2u*)(W_SHIN + (size_t)(cb + k) * 65536 + 4 * e4) = o;
            hc = hc * dc[k] + s[k]; } }
}
__device__ __forceinline__ void ssd_phase_e(Frame& F, int l, int ufirst, int uend, int ustride) {
    LAS unsigned char* L = F.lds;
    LAS bf16* Bs = (LAS bf16*)L;
    LAS bf16* XDT = (LAS bf16*)(L + 34816);
    LAS float* acum = (LAS float*)(L + 104448);
    const int tid = F.tid, lane = F.lane, w = F.wave, r16 = lane & 15, kq = lane >> 4;
    for (int u = ufirst; u < uend; u += ustride) { const int c = u >> 1, g = u & 1, t0 = c * 128;
        LAS float* dts = acum + 512;
        { const int t = tid & 127, hl = tid >> 7, h = 4 * g + hl;
          acum[hl * 128 + t] = W_ACUM[(size_t)(t0 + t) * 8 + h]; dts[hl * 128 + t] = softplus_f(W_SMALL[(size_t)(t0 + t) * 16 + h] + P_ssm_dt_bias[l * 8 + h]); }
        { const int c16 = tid & 15, tq = tid >> 4;
#pragma unroll
          for (int tp = 0; tp < 4; ++tp) { const int t = tq + 32 * tp; *(LAS v4u*)(Bs + t * 136 + 8 * c16) = *(const v4u*)(W_XBCB + (size_t)(t0 + t) * 1024 + 512 + g * 128 + 8 * c16); } }
        __syncthreads();
        { const int c32 = tid & 31, tq = tid >> 5, hl = c32 >> 3, p0 = 8 * (c32 & 7);
#pragma unroll 2
          for (int tp = 0; tp < 8; ++tp) { const int t = tq + 16 * tp; float xv[8]; unpack8(*(const v4u*)(W_XBCB + (size_t)(t0 + t) * 1024 + g * 256 + 8 * c32), xv);
              const float dt = dts[hl * 128 + t];
              const int tpm = (t & ~31) + 8 * ((t >> 2) & 3) + 4 * ((t >> 4) & 1) + (t & 3);
#pragma unroll
              for (int e = 0; e < 8; ++e) { const int row = hl * 64 + p0 + e; XDT[row * 136 + (tpm ^ (((row >> 3) & 15) << 3))] = (bf16)f2bf(xv[e] * dt); } } }
        __syncthreads();
        { const int tl = 16 * w + r16, tok = t0 + tl;
          bf16x8 cf[4];
#pragma unroll
          for (int ks = 0; ks < 4; ++ks) cf[ks] = *(const bf16x8*)(W_XBCB + (size_t)tok * 1024 + 768 + g * 128 + 32 * ks + 8 * kq);
          f32x4 gt[8];
#pragma unroll
          for (int st = 0; st < 8; ++st) { f32x4 d = (f32x4){0.f, 0.f, 0.f, 0.f};
              if (st <= w) {
#pragma unroll
                  for (int ks = 0; ks < 4; ++ks) { const bf16x8 a = *(const LAS bf16x8*)(Bs + (16 * st + r16) * 136 + 32 * ks + 8 * kq); d = MFMA16(a, cf[ks], d); } }
              gt[st] = d; }
          float ss = 0.f;
#pragma unroll 1
          for (int hl = 0; hl < 4; ++hl) { const int h = 4 * g + hl; const float al = acum[hl * 128 + tl];
              f32x4 yd[4], yo[4];
#pragma unroll
              for (int pt = 0; pt < 4; ++pt) { yd[pt] = (f32x4){0.f, 0.f, 0.f, 0.f}; yo[pt] = (f32x4){0.f, 0.f, 0.f, 0.f}; }
#pragma unroll
              for (int k2 = 0; k2 < 4; ++k2) { if (2 * k2 <= w) {
                  v4u sp;
#pragma unroll
                  for (int a = 0; a < 2; ++a) { const int s0 = 32 * k2 + 16 * a + 4 * kq; const f32x4 as = *(const LAS f32x4*)(acum + hl * 128 + s0); float v[4];
#pragma unroll
                      for (int b = 0; b < 4; ++b) v[b] = (s0 + b <= tl) ? gt[2 * k2 + a][b] * __expf(al - as[b]) : 0.f;
                      if (a == 0) { sp.x = pk2(v[0], v[1]); sp.y = pk2(v[2], v[3]); } else { sp.z = pk2(v[0], v[1]); sp.w = pk2(v[2], v[3]); } }
                  const bf16x8 sf = __builtin_bit_cast(bf16x8, sp);
#pragma unroll
                  for (int pt = 0; pt < 4; ++pt) { const int row = hl * 64 + 16 * pt + r16; const bf16x8 xa = *(const LAS bf16x8*)(XDT + row * 136 + 8 * ((4 * k2 + kq) ^ ((row >> 3) & 15))); yd[pt] = MFMA16(xa, sf, yd[pt]); } } }
              const bf16* hin = W_SHIN + (((size_t)c * 8 + h) * 64 + r16) * 128 + 8 * kq;
              { bf16x8 hfr[4][4];
#pragma unroll
                for (int pt = 0; pt < 4; ++pt)
#pragma unroll
                    for (int ks = 0; ks < 4; ++ks) hfr[pt][ks] = *(const bf16x8*)(hin + pt * 16 * 128 + 32 * ks);
#pragma unroll
                for (int pt = 0; pt < 4; ++pt)
#pragma unroll
                    for (int ks = 0; ks < 4; ++ks) yo[pt] = MFMA16(hfr[pt][ks], cf[ks], yo[pt]); }
              const float eal = __expf(al), Dh = P_ssm_d[l * 8 + h];
#pragma unroll
              for (int pt = 0; pt < 4; ++pt) { const int ch = g * 256 + hl * 64 + 16 * pt + 4 * kq;
                  const v2u xr = *(const v2u*)(W_XBCB + (size_t)tok * 1024 + ch); const v2u zr = *(const v2u*)(W_PROJ + (size_t)tok * NPROJ + C_Z + ch);
                  f32x4 y = yd[pt] + eal * yo[pt]; y[0] += Dh * bflo(xr.x); y[1] += Dh * bfhi(xr.x); y[2] += Dh * bflo(xr.y); y[3] += Dh * bfhi(xr.y);
                  y[0] *= silu_f(bflo(zr.x)); y[1] *= silu_f(bfhi(zr.x)); y[2] *= silu_f(bflo(zr.y)); y[3] *= silu_f(bfhi(zr.y));
                  v2u o; o.x = pk2(y[0], y[1]); o.y = pk2(y[2], y[3]);
                  ss += (bflo(o.x) * bflo(o.x) + bfhi(o.x) * bfhi(o.x)) + (bflo(o.y) * bflo(o.y) + bfhi(o.y) * bfhi(o.y));
                  *(v2u*)(W_YBR + (size_t)tok * 512 + ch) = o; } }
          ss += __shfl_xor(ss, 16); ss += __shfl_xor(ss, 32);
          const float rs = rsqrtf(ss * (1.0f / 256.0f) + EPS);
#pragma unroll
          for (int hl = 0; hl < 4; ++hl)
#pragma unroll
              for (int pt = 0; pt < 4; ++pt) { const int ch = g * 256 + hl * 64 + 16 * pt + 4 * kq; const f32x4 gn = *(const f32x4*)(P_ssm_norm + l * 512 + ch);
                  const v2u yv = *(const v2u*)(W_YBR + (size_t)tok * 512 + ch);
                  v2u o; o.x = pk2(bflo(yv.x) * rs * gn[0], bfhi(yv.x) * rs * gn[1]); o.y = pk2(bflo(yv.y) * rs * gn[2], bfhi(yv.y) * rs * gn[3]);
                  *(v2u*)(W_YBR + (size_t)tok * 512 + ch) = o; } }
        __syncthreads();
    }
}


__device__ __forceinline__ void sb_mfma_unit(Frame& F, int l, int hh, int qb) {
    LAS bf16* Ks = (LAS bf16*)F.lds;
    LAS bf16* VT = Ks + 64 * 136;
    LAS float* red = (LAS float*)(F.lds + 35840);
    const int tid = F.tid, lane = F.lane, w = F.wave, r16 = lane & 15, kq = lane >> 4, q0 = qb * 128, tg = q0 + 16 * w + r16;
    bf16x8 qf[4];
    { const bf16* qp = W_PROJ + (size_t)tg * NPROJ + C_SBQKV + hh * 128 + 8 * kq; float qv[4][8]; float ss = 0.f;
#pragma unroll
      for (int ks = 0; ks < 4; ++ks) { unpack8(*(const v4u*)(qp + 32 * ks), qv[ks]);
#pragma unroll
          for (int e = 0; e < 8; ++e) ss += qv[ks][e] * qv[ks][e]; }
      ss += __shfl_xor(ss, 16); ss += __shfl_xor(ss, 32);
      const float rs = rsqrtf(ss * (1.0f / 128.0f) + EPS) * 0.08838834764831845f; const float* qg = P_sb_q_norm + l * 128 + 8 * kq;
#pragma unroll
      for (int ks = 0; ks < 4; ++ks) { v4u p; p.x = pk2(qv[ks][0] * rs * qg[32 * ks], qv[ks][1] * rs * qg[32 * ks + 1]); p.y = pk2(qv[ks][2] * rs * qg[32 * ks + 2], qv[ks][3] * rs * qg[32 * ks + 3]);
          p.z = pk2(qv[ks][4] * rs * qg[32 * ks + 4], qv[ks][5] * rs * qg[32 * ks + 5]); p.w = pk2(qv[ks][6] * rs * qg[32 * ks + 6], qv[ks][7] * rs * qg[32 * ks + 7]); qf[ks] = __builtin_bit_cast(bf16x8, p); } }
    f32x4 oacc[8];
#pragma unroll
    for (int i = 0; i < 8; ++i) oacc[i] = (f32x4){0.f, 0.f, 0.f, 0.f};
    float accrow = 0.f;
    v4u kraw[2], vraw[2];
    { const bf16* kp = W_PROJ + (size_t)(64 * (2 * qb + 1) + (tid >> 3)) * NPROJ + C_SBQKV + 512 + hh * 128 + 16 * (tid & 7);
      kraw[0] = *(const v4u*)kp; kraw[1] = *(const v4u*)(kp + 8); vraw[0] = *(const v4u*)(kp + 512); vraw[1] = *(const v4u*)(kp + 520); }
    for (int jb = 2 * qb + 1; jb >= 0; --jb) {
        { const int kr = tid >> 3, k8 = tid & 7; float kv[16]; float ss = 0.f;
          const v4u v0 = vraw[0], v1 = vraw[1];
          unpack8(kraw[0], kv); unpack8(kraw[1], kv + 8);
#pragma unroll
          for (int e = 0; e < 16; ++e) ss += kv[e] * kv[e];
          ss += __shfl_xor(ss, 1); ss += __shfl_xor(ss, 2); ss += __shfl_xor(ss, 4);
          const float rk = rsqrtf(ss * (1.0f / 128.0f) + EPS); const float* kg = P_sb_k_norm + l * 128 + 16 * k8;
          v4u o0, o1; o0.x = pk2(kv[0] * rk * kg[0], kv[1] * rk * kg[1]); o0.y = pk2(kv[2] * rk * kg[2], kv[3] * rk * kg[3]); o0.z = pk2(kv[4] * rk * kg[4], kv[5] * rk * kg[5]); o0.w = pk2(kv[6] * rk * kg[6], kv[7] * rk * kg[7]);
          o1.x = pk2(kv[8] * rk * kg[8], kv[9] * rk * kg[9]); o1.y = pk2(kv[10] * rk * kg[10], kv[11] * rk * kg[11]); o1.z = pk2(kv[12] * rk * kg[12], kv[13] * rk * kg[13]); o1.w = pk2(kv[14] * rk * kg[14], kv[15] * rk * kg[15]);
          *(LAS v4u*)(Ks + kr * 136 + 16 * k8) = o0; *(LAS v4u*)(Ks + kr * 136 + 16 * k8 + 8) = o1;
          const int sp = (kr & ~31) + 8 * ((kr >> 2) & 3) + 4 * ((kr >> 4) & 1) + (kr & 3);
          const unsigned vw[8] = {v0.x, v0.y, v0.z, v0.w, v1.x, v1.y, v1.z, v1.w};
#pragma unroll
          for (int e = 0; e < 8; ++e) { VT[(16 * k8 + 2 * e) * 72 + sp] = (bf16)(vw[e] & 0xffffu); VT[(16 * k8 + 2 * e + 1) * 72 + sp] = (bf16)(vw[e] >> 16); } }
        __syncthreads();
        if (jb > 0) { const bf16* kp = W_PROJ + (size_t)(64 * (jb - 1) + (tid >> 3)) * NPROJ + C_SBQKV + 512 + hh * 128 + 16 * (tid & 7);
            kraw[0] = *(const v4u*)kp; kraw[1] = *(const v4u*)(kp + 8); vraw[0] = *(const v4u*)(kp + 512); vraw[1] = *(const v4u*)(kp + 520); }
        if (64 * jb <= q0 + 16 * w + 15) {
            f32x4 st[4];
#pragma unroll
            for (int i = 0; i < 4; ++i) { f32x4 d = (f32x4){0.f, 0.f, 0.f, 0.f};
#pragma unroll
                for (int ks = 0; ks < 4; ++ks) { const bf16x8 a = *(const LAS bf16x8*)(Ks + (16 * i + r16) * 136 + 32 * ks + 8 * kq); d = MFMA16(a, qf[ks], d); }
                st[i] = d; }
            float carry = accrow; unsigned pw[4][2];
#pragma unroll
            for (int i = 3; i >= 0; --i) { float lb[4], lk[4];
#pragma unroll
                for (int j = 0; j < 4; ++j) { const float z = st[i][j]; const bool valid = (64 * jb + 16 * i + 4 * kq + j) < tg;
                    const float b = fminf(z, 0.f) - __logf(1.0f + __expf(-fabsf(z))); lb[j] = valid ? b : -INFINITY; lk[j] = valid ? b - z : 0.f; }
                const float q = (lk[0] + lk[1]) + (lk[2] + lk[3]);
                const float v1 = __shfl_xor(q, 16), v2 = __shfl_xor(q, 32), v3 = __shfl_xor(v1, 32);
                const float hi = kq == 0 ? (v1 + v2 + v3) : (kq == 1 ? (v2 + v3) : (kq == 2 ? v1 : 0.f));
                const float base = carry + hi;
                const float p3 = __expf(lb[3] + base), p2 = __expf(lb[2] + base + lk[3]), p1 = __expf(lb[1] + base + lk[3] + lk[2]), p0 = __expf(lb[0] + base + lk[3] + lk[2] + lk[1]);
                pw[i][0] = pk2(p0, p1); pw[i][1] = pk2(p2, p3);
                carry += (q + v1) + (v2 + v3); }
            accrow = carry;
#pragma unroll
            for (int k2 = 0; k2 < 2; ++k2) { v4u pp; pp.x = pw[2 * k2][0]; pp.y = pw[2 * k2][1]; pp.z = pw[2 * k2 + 1][0]; pp.w = pw[2 * k2 + 1][1]; const bf16x8 pf = __builtin_bit_cast(bf16x8, pp);
#pragma unroll
                for (int dt = 0; dt < 8; ++dt) { const bf16x8 a = *(const LAS bf16x8*)(VT + (16 * dt + r16) * 72 + 32 * k2 + 8 * kq); oacc[dt] = MFMA16(a, pf, oacc[dt]); } }
        }
        float mx = accrow;
#pragma unroll
        for (int of = 1; of < 64; of <<= 1) mx = fmaxf(mx, __shfl_xor(mx, of));
        if (lane == 0) red[w] = mx;
        __syncthreads();
        float m = red[0];
#pragma unroll
        for (int i = 1; i < 8; ++i) m = fmaxf(m, red[i]);
        if (m < -104.0f) break;
    }
    bf16* op = W_YBR + (size_t)SEQ * 512 + (size_t)tg * 512 + hh * 128 + 4 * kq;
#pragma unroll
    for (int dt = 0; dt < 8; ++dt) { v2u o; o.x = pk2(oacc[dt][0], oacc[dt][1]); o.y = pk2(oacc[dt][2], oacc[dt][3]); *(v2u*)(op + 16 * dt) = o; }
    __syncthreads();
}
__device__ __forceinline__ void phase_mix1(Frame& F, int l) {
    if (F.vcu < 32) ssd_scan(F);
    else if (F.vcu < 160) { const int u = F.vcu - 32; gdn_seg<1>(F, u >> 5, (u >> 1) & 15, u & 1); }
    LAS int* nxt = (LAS int*)(F.lds + MISC_OFF + 512);
    for (;;) {
        __syncthreads();
        if (F.tid == 0) *nxt = (int)atomicAdd(F.ctl + CW_SBQ + l * 64, 1u);
        __syncthreads();
        const int u = *nxt; if (u >= 512) break;
        sb_mfma_unit(F, l, u & 3, 127 - (u >> 2));
    }
}
__device__ __forceinline__ void phase_mix2(Frame& F, int l) {
    if (F.vcu < 8) gdn_seg<2>(F, F.vcu >> 1, 0, F.vcu & 1);
    else ssd_phase_e(F, l, F.vcu - 8, 248, F.G);
}
__device__ __forceinline__ void phase_mix3(Frame& F, int l) {
    if (F.vcu < 128) gdn_seg<3>(F, F.vcu >> 5, (F.vcu >> 1) & 15, F.vcu & 1);
    else if (F.vcu < 136) ssd_phase_e(F, l, 248 + F.vcu - 128, 256, 8);
}

__device__ __forceinline__ void phase_final(Frame& F) {
    const int lane = F.lane, gw = F.vcu * NWAVES + F.wave, NGW = F.G * NWAVES;
    f32x4 G4[4];
#pragma unroll
    for (int j = 0; j < 4; ++j) G4[j] = modv4<true>(F, NL - 1, 5, j * 256 + 4 * lane);
    LAS int* ttab = (LAS int*)(F.lds + MISC_OFF + 3072); build_tile_table(F, NL - 1, ttab);
    for (int m = gw; m < SEQ; m += NGW) {
        const int s0 = ttab[W_PAIRE[2 * m]] * 256 + W_PAIRS[2 * m], s1 = ttab[W_PAIRE[2 * m + 1]] * 256 + W_PAIRS[2 * m + 1]; const float w0 = W_PAIRW[2 * m], w1 = W_PAIRW[2 * m + 1];
        const v2u* y0 = (const v2u*)(W_YP + (size_t)s0 * 1024); const v2u* y1 = (const v2u*)(W_YP + (size_t)s1 * 1024);
#pragma unroll
        for (int j = 0; j < 4; ++j) { const v2u a = y0[64 * j + lane], b = y1[64 * j + lane]; f32x4 v = ((const f32x4*)(F.out + (size_t)m * 1024))[64 * j + lane];
            f32x4 y; y[0] = w0 * bflo(a.x) + w1 * bflo(b.x); y[1] = w0 * bfhi(a.x) + w1 * bfhi(b.x); y[2] = w0 * bflo(a.y) + w1 * bflo(b.y); y[3] = w0 * bfhi(a.y) + w1 * bfhi(b.y);
            ((f32x4*)(F.out + (size_t)m * 1024))[64 * j + lane] = v + G4[j] * y; }
    }
}

struct Args { const float* in[28]; float* out; unsigned char* ws; int ph_lo, ph_hi, li, pad; };
__global__ void __launch_bounds__(NWAVES * 64, 2) mk_fwd(Args args) {
    extern __shared__ __attribute__((aligned(16))) unsigned char lds[];
    Frame F;
    F.lds = (LAS unsigned char*)lds;
    F.tid = threadIdx.x; F.lane = F.tid & 63; F.wave = __builtin_amdgcn_readfirstlane(F.tid >> 6);
    F.G = gridDim.x; { const int bx = blockIdx.x; F.vcu = (F.G % 8 == 0) ? (bx % 8) * (F.G / 8) + bx / 8 : bx; }
    F.ws = args.ws; F.in = args.in; F.out = args.out;
    F.ctl = (unsigned*)(F.ws + WS_CTL);
    volatile LAS unsigned* MISC = (volatile LAS unsigned*)(F.lds + MISC_OFF);
    for (int u = F.tid; u < 128; u += NWAVES * 64) MISC[u] = 0u;
    __syncthreads();
    const int lo = args.ph_lo, hi = args.ph_hi; const int vcu0 = F.vcu;
    XcdBarrier bar; bar.bar = F.ctl + CW_BAR + args.li * XCD_BAR_WORDS; bar.x = 0; bar.st = nullptr;
    if (hi - lo > 1) bar = xcd_barrier_post(F.ctl + CW_BAR + args.li * XCD_BAR_WORDS, MISC + 8);
#define IN(k) (lo <= (k) && (k) < hi)
#define FRESH() do { int t_ = threadIdx.x; asm volatile("" : "+v"(t_)); F.tid = t_; F.lane = t_ & 63; F.wave = __builtin_amdgcn_readfirstlane(t_ >> 6); \
        int v_ = vcu0, g_ = (int)gridDim.x; asm volatile("" : "+s"(v_), "+s"(g_)); F.vcu = v_; F.G = g_; \
        } while (0)
#define SEAM(k) do { if ((k) + 1 < hi) xcd_barrier(bar); } while (0)

    if (IN(0)) { FRESH(); p0_prologue(F); SEAM(0); }
    for (int l = 0; l < NL; ++l) {
        const int pb = 1 + 13 * l;
        if (IN(pb + 0)) { FRESH(); phase_norm<false>(F, l); SEAM(pb + 0); }
        if (IN(pb + 1)) { FRESH();
            pg8::Gemm g{W_HB, W_WIN + (size_t)l * 8192 * 1024, 1024, 0, 0}; pg8::StaticOrder S; S.init(SEQ, 8192, F.G, (int)blockIdx.x);
            pg8::EpiProj E{W_PROJ, NPROJ, C_BRG / 256, W_GATES};
            pg8::gemm_phase(F.lds, g, S, E); SEAM(pb + 1); }
        if (IN(pb + 2)) { FRESH(); gdn_phase_x(F, l); FRESH(); ssd_phase_c(F, l); SEAM(pb + 2); }
        if (IN(pb + 3)) { FRESH(); phase_mix1(F, l); SEAM(pb + 3); }
        if (IN(pb + 4)) { FRESH(); phase_mix2(F, l); SEAM(pb + 4); }
        if (IN(pb + 5)) { FRESH(); phase_mix3(F, l); SEAM(pb + 5); }
        if (IN(pb + 6)) { FRESH(); gdn_phase_z(F, l); SEAM(pb + 6); }
        if (IN(pb + 7)) { FRESH();
            pg8::Gemm g{W_YBR, W_WBR + (size_t)l * 3 * 1024 * 512, 512, (size_t)SEQ * 512 * 2, (size_t)1024 * 512 * 2}; pg8::BranchOrder S; S.so.init(SEQ, 1024, F.G, (int)blockIdx.x);
            pg8::EpiBranch E{W_GATES, W_MERGED};
            pg8::gemm_phase(F.lds, g, S, E); SEAM(pb + 7); }
        if (IN(pb + 8)) { FRESH();
            pg8::Gemm g{W_MERGED, W_WOUT + (size_t)l * 1024 * 1024, 1024, 0, 0}; pg8::StaticOrder S; S.init(SEQ, 1024, F.G, (int)blockIdx.x);
            pg8::EpiOut E{l == 0 ? P_x : F.out, F.out, W_MODF + l * 6144 + 2 * 1024};
            pg8::gemm_phase(F.lds, g, S, E); SEAM(pb + 8); }
        if (IN(pb + 9)) { FRESH(); phase_norm<true>(F, l); SEAM(pb + 9); }
        if (IN(pb + 11)) { FRESH();
            LAS int* tab = (LAS int*)(F.lds + MISC_OFF + 3072); const int nt = build_tile_table(F, l, tab);
            pg8::Gemm g{W_HB, W_WGU + (size_t)l * 32 * 1024 * 1024, 1024, 0, (size_t)1024 * 1024 * 2}; pg8::ExpertOrder S{tab, F.G, F.vcu, nt};
            pg8::EpiAct E{W_ACT}; pg8::Gather GI{W_TOKOF, tab, tab + 64};
            pg8::gemm_phase<pg8::EpiAct, pg8::ExpertOrder, true>(F.lds, g, S, E, GI); SEAM(pb + 11); }
        if (IN(pb + 12)) { FRESH();
            LAS int* tab = (LAS int*)(F.lds + MISC_OFF + 3072); const int nt = build_tile_table(F, l, tab);
            pg8::Gemm g{W_ACT, W_WD + (size_t)l * 32 * 1024 * 512, 512, 0, (size_t)1024 * 512 * 2}; pg8::ExpertOrder S{tab, F.G, F.vcu, nt};
            pg8::EpiBf16 E{W_YP};
            pg8::gemm_phase(F.lds, g, S, E); SEAM(pb + 12); }
    }
    if (IN(53)) { FRESH(); phase_final(F); }
#undef IN
#undef SEAM
}

extern "C" void kernel_launch(void* const* d_in, const int* in_sizes, int n_in, void* d_out, int out_size, void* d_ws, size_t ws_size, hipStream_t stream) {
    static int grid = 0;
    if (grid == 0) {
        if (n_in != 28 || in_sizes[0] != SEQ * DM || out_size != SEQ * DM || ws_size < WS_END) {
            fprintf(stderr, "kernel_launch: built for 28 inputs, x/out of %d floats, >= %zu bytes of workspace; got n_in %d in0 %d out %d ws %zu\n", SEQ * DM, (size_t)WS_END, n_in, n_in > 0 ? in_sizes[0] : -1, out_size, ws_size); grid = -1; return; }
        int dev = 0, cus = 0, per_cu = 0;
        if (hipGetDevice(&dev) != hipSuccess || hipDeviceGetAttribute(&cus, hipDeviceAttributeMultiprocessorCount, dev) != hipSuccess) { fprintf(stderr, "kernel_launch: device query failed\n"); grid = -1; return; }
        if (hipFuncSetAttribute((const void*)mk_fwd, hipFuncAttributeMaxDynamicSharedMemorySize, LDS_BYTES) != hipSuccess) { fprintf(stderr, "kernel_launch: hipFuncSetAttribute failed\n"); grid = -1; return; }
        if (hipOccupancyMaxActiveBlocksPerMultiprocessor(&per_cu, (const void*)mk_fwd, NWAVES * 64, LDS_BYTES) != hipSuccess || per_cu < 1)
            fprintf(stderr, "kernel_launch: occupancy query reports %d workgroups per CU\n", per_cu);
        (void)hipGetLastError();
        grid = cus;
    }
    if (grid < 0) return;
    if (hipMemsetAsync((char*)d_ws + WS_CTL, 0, CTL_ZERO_BYTES, stream) != hipSuccess) { fprintf(stderr, "kernel_launch: memset failed\n"); return; }
    Args a{};
    for (int i = 0; i < 28; ++i) a.in[i] = (const float*)d_in[i];
    a.out = (float*)d_out; a.ws = (unsigned char*)d_ws; a.pad = 0;
#if MK_SPLIT
    for (int p = 0; p < N_PHASES; ++p) { a.ph_lo = p; a.ph_hi = p + 1; a.li = 0;
        hipLaunchKernelGGL(mk_fwd, dim3(grid), dim3(NWAVES * 64), LDS_BYTES, stream, a);
        const hipError_t le = hipPeekAtLastError();
        if (le != hipSuccess) { fprintf(stderr, "kernel_launch: launch %d failed: %s\n", p, hipGetErrorName(le)); break; } }
#else
    a.ph_lo = 0; a.ph_hi = N_PHASES; a.li = 0;
    hipLaunchKernelGGL(mk_fwd, dim3(grid), dim3(NWAVES * 64), LDS_BYTES, stream, a);
    const hipError_t le = hipPeekAtLastError();
    if (le != hipSuccess) fprintf(stderr, "kernel_launch: launch failed: %s\n", hipGetErrorName(le));
#endif
}
```

```cpp
#include <hip/hip_runtime.h>
#include <cstdio>
#include <cstdint>

#ifndef MK_SPLIT
#define MK_SPLIT 0
#endif

namespace pg8 {
#define PG8_LAS __attribute__((address_space(3)))
typedef unsigned short bf16_t;
typedef short bf16x8 __attribute__((ext_vector_type(8)));
typedef float f32x4 __attribute__((ext_vector_type(4)));
typedef unsigned u32x4 __attribute__((ext_vector_type(4)));
typedef unsigned u32x2 __attribute__((ext_vector_type(2)));
constexpr int BM = 256, BK = 64, HALF = 128, HTB = HALF * BK * 2, STAGE_BYTES = 8 * HTB, NXCD = 8, WGM = 8;

__host__ __device__ __forceinline__ int lds_byte(int r, int c) { const int st = (r >> 4) * 2 + (c >> 5), rr = r & 15, cc = c & 31, ob = rr * 64 + cc * 2; return st * 1024 + (ob ^ (((ob >> 9) & 1) << 5)); }
__host__ __device__ __forceinline__ void stage_rc(int b, int& R, int& C) { const int st = b / 1024, sb = b % 1024, swz = sb ^ (((sb >> 9) & 1) << 5); R = (st >> 1) * 16 + swz / 64; C = (st & 1) * 32 + (swz % 64) / 2; }
__host__ __device__ __forceinline__ int perm32(int rho) { const int n = rho >> 4, i = rho & 15; return 8 * (i >> 2) + 4 * n + (i & 3); }

struct Unit { int pm, pn, z; };
struct Gemm { const bf16_t* A; const bf16_t* Bt; int K; size_t zsA, zsB; };

struct StaticOrder {
    int nM, nN, nwg, G, c;
    __host__ __device__ void init(int M, int N, int G_, int c_) { nM = M / BM; nN = N / BM; nwg = nM * nN; G = G_; c = c_; }
    __host__ __device__ bool map(long L, Unit& u) const {
        if (L >= nwg) return false;
        int wgid = (int)L; { const int q = nwg / NXCD, r = nwg % NXCD, xcd = wgid % NXCD, off = wgid / NXCD; wgid = (xcd < r ? xcd * (q + 1) : r * (q + 1) + (xcd - r) * q) + off; }
        const int nig = WGM * nN, gid = wgid / nig, fm = gid * WGM, gsz = (nM - fm) < WGM ? (nM - fm) : WGM;
        u.pm = fm + ((wgid % nig) % gsz); u.pn = (wgid % nig) / gsz; u.z = 0; return true;
    }
    __host__ __device__ bool next(int i, Unit& u) const { return map((long)i * G + c, u); }
};
struct BranchOrder {
    StaticOrder so;
    __device__ bool next(int i, Unit& u) const { const int rd = i / 3; const bool ok = so.map((long)rd * so.G + so.c, u); u.z = i - 3 * rd; return ok; }
};
struct ExpertOrder {
    const PG8_LAS int* tab; int G, c, ntiles;
    __device__ bool next(int i, Unit& u) const {
        const int L = i * G + c, rt = L >> 2; if (rt >= ntiles) return false;
        int e = 0; const PG8_LAS int* tb = tab; asm volatile("" : "+v"(tb));
        for (int k = 1; k < 32; ++k) e += (tb[k] <= rt) ? 1 : 0;
        e = __builtin_amdgcn_readfirstlane(e);
        u.pm = rt; u.pn = L & 3; u.z = e; return true;
    }
};

__device__ __forceinline__ unsigned cvt_pk_bf16(float lo, float hi) { unsigned r; asm volatile("v_cvt_pk_bf16_f32 %0, %1, %2" : "=v"(r) : "v"(lo), "v"(hi)); return r; }
__device__ __forceinline__ float fsigmoid(float x) { return __builtin_amdgcn_rcpf(1.0f + __expf(-x)); }

struct EpiProj {
    static constexpr bool PERM = true;
    __device__ __forceinline__ bool keep(const Unit&) const { return false; }
    bf16_t* O; int ldc; int sig_pn; bf16_t* gates;
    __device__ __forceinline__ void operator()(const f32x4 (&acc)[2][2][4][2], const Unit& u, int wr, int wc, int fr, int fq) const {
        const int row0 = u.pm * BM + wr * 64 + fr, col0 = u.pn * BM + wc * 32 + 8 * fq; const bool sg = u.pn >= sig_pn;
        if (!sg) {
#pragma unroll
            for (int ai = 0; ai < 2; ++ai)
#pragma unroll
                for (int m = 0; m < 4; ++m) { bf16_t* rowp = O + (size_t)(row0 + ai * HALF + m * 16) * ldc + col0;
#pragma unroll
                    for (int bj = 0; bj < 2; ++bj) { const f32x4 v0 = acc[ai][bj][m][0], v1 = acc[ai][bj][m][1];
                        u32x4 w; w.x = cvt_pk_bf16(v0[0], v0[1]); w.y = cvt_pk_bf16(v0[2], v0[3]); w.z = cvt_pk_bf16(v1[0], v1[1]); w.w = cvt_pk_bf16(v1[2], v1[3]);
                        *(u32x4*)(rowp + bj * HALF) = w; } }
        } else { const int z = (u.pn - sig_pn) >> 2, pq = (u.pn - sig_pn) & 3;
            bf16_t* gb = gates + ((((size_t)(z * 64 + u.pm) * 4 + pq) * 2 + wr) * 4 + wc) * 2 * 4 * 64 * 16 + (size_t)((2 * (fq & 1)) * 16 + fr) * 16 + (fq >> 1) * 4;
#pragma unroll
            for (int ai = 0; ai < 2; ++ai)
#pragma unroll
                for (int m = 0; m < 4; ++m)
#pragma unroll
                    for (int bj = 0; bj < 2; ++bj) { f32x4 v0 = acc[ai][bj][m][0], v1 = acc[ai][bj][m][1];
#pragma unroll
                        for (int j = 0; j < 4; ++j) { v0[j] = fsigmoid(v0[j]); v1[j] = fsigmoid(v1[j]); }
                        bf16_t* p = gb + (size_t)(ai * 4 + m) * 64 * 16 + bj * 8;
                        u32x2 w0, w1; w0.x = cvt_pk_bf16(v0[0], v0[1]); w0.y = cvt_pk_bf16(v0[2], v0[3]); w1.x = cvt_pk_bf16(v1[0], v1[1]); w1.y = cvt_pk_bf16(v1[2], v1[3]);
                        *(u32x2*)p = w0; *(u32x2*)(p + 16 * 16) = w1; } }
    }
};
struct EpiAct {
    static constexpr bool PERM = true;
    __device__ __forceinline__ bool keep(const Unit&) const { return false; }
    bf16_t* O;
    __device__ __forceinline__ void operator()(const f32x4 (&acc)[2][2][4][2], const Unit& u, int wr, int wc, int fr, int fq) const {
        const int row0 = u.pm * BM + wr * 64 + fr, col0 = u.pn * HALF + wc * 32 + 8 * fq;
#pragma unroll
        for (int ai = 0; ai < 2; ++ai)
#pragma unroll
            for (int m = 0; m < 4; ++m) { bf16_t* rowp = O + (size_t)(row0 + ai * HALF + m * 16) * 512 + col0;
                f32x4 a0, a1;
#pragma unroll
                for (int j = 0; j < 4; ++j) { const float g0 = acc[ai][0][m][0][j], g1 = acc[ai][0][m][1][j];
                    a0[j] = g0 * fsigmoid(g0) * acc[ai][1][m][0][j]; a1[j] = g1 * fsigmoid(g1) * acc[ai][1][m][1][j]; }
                u32x4 w; w.x = cvt_pk_bf16(a0[0], a0[1]); w.y = cvt_pk_bf16(a0[2], a0[3]); w.z = cvt_pk_bf16(a1[0], a1[1]); w.w = cvt_pk_bf16(a1[2], a1[3]);
                *(u32x4*)rowp = w; }
    }
};
struct EpiOut {
    static constexpr bool PERM = false;
    __device__ __forceinline__ bool keep(const Unit&) const { return false; }
    const float* base; float* out; const float* gate;
    __device__ __forceinline__ void operator()(const f32x4 (&acc)[2][2][4][2], const Unit& u, int wr, int wc, int fr, int fq) const {
        const int row0 = u.pm * BM + wr * 64 + fr, col0 = u.pn * BM + wc * 32 + 4 * fq;
        f32x4 gv[2][2];
#pragma unroll
        for (int bj = 0; bj < 2; ++bj)
#pragma unroll
            for (int n = 0; n < 2; ++n) gv[bj][n] = *(const f32x4*)(gate + col0 + bj * HALF + n * 16);
#pragma unroll
        for (int ai = 0; ai < 2; ++ai)
#pragma unroll
            for (int m = 0; m < 4; ++m) { const size_t off = (size_t)(row0 + ai * HALF + m * 16) * 1024 + col0;
#pragma unroll
                for (int bj = 0; bj < 2; ++bj)
#pragma unroll
                    for (int n = 0; n < 2; ++n) { const f32x4 b = *(const f32x4*)(base + off + bj * HALF + n * 16);
                        *(f32x4*)(out + off + bj * HALF + n * 16) = b + gv[bj][n] * acc[ai][bj][m][n]; }
                if (m & 1) asm volatile("" ::: "memory"); }
    }
};
struct EpiBranch {
    static constexpr bool PERM = false;
    const bf16_t* gates; bf16_t* merged;
    __device__ __forceinline__ bool keep(const Unit& u) const { return u.z < 2; }
    __device__ __forceinline__ void operator()(f32x4 (&acc)[2][2][4][2], const Unit& u, int wr, int wc, int fr, int fq) const {
        const int row0 = u.pm * BM + wr * 64 + fr, col0 = u.pn * BM + wc * 32 + 4 * fq; const float tiny = 8.673617379884035e-19f;
        const bf16_t* gb = gates + ((((size_t)(u.z * 64 + u.pm) * 4 + u.pn) * 2 + wr) * 4 + wc) * 2 * 4 * 64 * 16 + (size_t)(fq * 16 + fr) * 16;
        const size_t zs = (size_t)64 * 4 * 2 * 4 * 2 * 4 * 64 * 16;
#pragma unroll
        for (int ai = 0; ai < 2; ++ai)
#pragma unroll
            for (int m = 0; m < 4; ++m) { const size_t off = (size_t)(row0 + ai * HALF + m * 16) * 1024 + col0; const bf16_t* gp = gb + (size_t)(ai * 4 + m) * 64 * 16;
                const u32x4 ga = *(const u32x4*)gp, gbv = *(const u32x4*)(gp + 8); u32x4 ha = ga, hb = gbv;
                if (u.z < 2) { ha = *(const u32x4*)(gp + zs); hb = *(const u32x4*)(gp + zs + 8); }
                const unsigned gw[8] = {ga.x, ga.y, ga.z, ga.w, gbv.x, gbv.y, gbv.z, gbv.w}, hw[8] = {ha.x, ha.y, ha.z, ha.w, hb.x, hb.y, hb.z, hb.w};
#pragma unroll
                for (int bj = 0; bj < 2; ++bj)
#pragma unroll
                    for (int n = 0; n < 2; ++n) { const int q = (bj * 2 + n) * 2; const int co = bj * HALF + n * 16;
                        f32x4 g; g[0] = __uint_as_float(gw[q] << 16); g[1] = __uint_as_float(gw[q] & 0xffff0000u); g[2] = __uint_as_float(gw[q + 1] << 16); g[3] = __uint_as_float(gw[q + 1] & 0xffff0000u);
#pragma unroll
                        for (int j = 0; j < 4; ++j) g[j] = fmaxf(g[j], tiny);
                        if (u.z < 2) { f32x4 h; h[0] = __uint_as_float(hw[q] << 16); h[1] = __uint_as_float(hw[q] & 0xffff0000u); h[2] = __uint_as_float(hw[q + 1] << 16); h[3] = __uint_as_float(hw[q + 1] & 0xffff0000u);
#pragma unroll
                            for (int j = 0; j < 4; ++j) g[j] *= __builtin_amdgcn_rcpf(fmaxf(h[j], tiny));
                            acc[ai][bj][m][n] = acc[ai][bj][m][n] * g; }
                        else { const f32x4 t = acc[ai][bj][m][n] * g; u32x2 w; w.x = cvt_pk_bf16(t[0], t[1]); w.y = cvt_pk_bf16(t[2], t[3]); *(u32x2*)(merged + off + co) = w; } }
                if ((m & 3) == 3) asm volatile("" ::: "memory"); }
    }
};
struct EpiBf16 {
    static constexpr bool PERM = true;
    __device__ __forceinline__ bool keep(const Unit&) const { return false; }
    bf16_t* O;
    __device__ __forceinline__ void operator()(const f32x4 (&acc)[2][2][4][2], const Unit& u, int wr, int wc, int fr, int fq) const {
        const int row0 = u.pm * BM + wr * 64 + fr, col0 = u.pn * BM + wc * 32 + 8 * fq;
#pragma unroll
        for (int ai = 0; ai < 2; ++ai)
#pragma unroll
            for (int m = 0; m < 4; ++m) { bf16_t* rowp = O + (size_t)(row0 + ai * HALF + m * 16) * 1024 + col0;
#pragma unroll
                for (int bj = 0; bj < 2; ++bj) { const f32x4 v0 = acc[ai][bj][m][0], v1 = acc[ai][bj][m][1];
                    u32x4 w; w.x = cvt_pk_bf16(v0[0], v0[1]); w.y = cvt_pk_bf16(v0[2], v0[3]); w.z = cvt_pk_bf16(v1[0], v1[1]); w.w = cvt_pk_bf16(v1[2], v1[3]);
                    *(u32x4*)(rowp + bj * HALF) = w; } }
    }
};

struct Gather { const int* tokof; const PG8_LAS int* tab; const PG8_LAS int* cnt; };
template <class Epi, class Sched, bool GATHER = false>
__device__ __forceinline__ void gemm_phase(PG8_LAS unsigned char* lds, const Gemm g, const Sched& S, const Epi& E, const Gather G = Gather{nullptr, nullptr, nullptr}) {
    int tid_ = threadIdx.x; asm volatile("" : "+v"(tid_));
    const int tid = tid_, wid = __builtin_amdgcn_readfirstlane(tid >> 6), lane = tid & 63, wr = wid >> 2, wc = wid & 3, fr = lane & 15, fq = lane >> 4;
    const int K = g.K, nt = K / BK;
    unsigned voffA[2], voffB[2]; int gR[2]; unsigned gC[2];
#pragma unroll
    for (int i = 0; i < 2; ++i) { int R, C; stage_rc(tid * 16 + i * 8192, R, C); const int Rb = Epi::PERM ? ((R & ~31) + perm32(R & 31)) : R;
        voffA[i] = (unsigned)(R * K + C) * 2u; voffB[i] = (unsigned)(Rb * K + C) * 2u; gR[i] = R; gC[i] = (unsigned)C * 2u; }
    unsigned gA[2][2], gN[2][2];
#define PG8_GLOAD(dst, u) do { const int e_ = (u).z, base_ = ((u).pm - G.tab[e_]) * 256, cn_ = G.cnt[e_]; _Pragma("unroll") for (int h_ = 0; h_ < 2; ++h_) _Pragma("unroll") for (int i_ = 0; i_ < 2; ++i_) { \
        const int pos_ = base_ + h_ * 128 + gR[i_]; const int tk_ = pos_ < cn_ ? G.tokof[e_ * 16384 + pos_] : 0; dst[h_][i_] = (unsigned)tk_ * (unsigned)(K * 2) + gC[i_]; } } while (0)
    const size_t kstep = (size_t)(BK * 2);
    const size_t hstep = (size_t)HALF * K * 2;
    const size_t tstep = 2 * hstep;
    const unsigned ldsw = (unsigned)wid * 1024u;
    const int aoff = lds_byte(wr * 64 + fr, fq * 8), boff = lds_byte(wc * 32 + fr, fq * 8);
#define PG8_SA(b, h) (((b) * 2 + (h)) * HTB)
#define PG8_SB(b, h) ((4 + (b) * 2 + (h)) * HTB)
#define PG8_STAGE(bufoff, gbase, voff) do { _Pragma("unroll") for (int _i = 0; _i < 2; ++_i) \
        __builtin_amdgcn_global_load_lds((const unsigned*)((const char*)(gbase) + (voff)[_i]), (PG8_LAS unsigned*)(lds + (bufoff) + ldsw + _i * 8192), 16, 0, 0); } while (0)
#define PG8_LDA(dst, b, h) do { _Pragma("unroll") for (int m = 0; m < 4; ++m) _Pragma("unroll") for (int k = 0; k < 2; ++k) dst[m][k] = *(const PG8_LAS bf16x8*)(lds + PG8_SA(b, h) + aoff + m * 2048 + k * 1024); } while (0)
#define PG8_LDB(dst, b, h) do { _Pragma("unroll") for (int n = 0; n < 2; ++n) _Pragma("unroll") for (int k = 0; k < 2; ++k) dst[n][k] = *(const PG8_LAS bf16x8*)(lds + PG8_SB(b, h) + boff + n * 2048 + k * 1024); } while (0)
#define PG8_MMA(ai, bj, At, Bt) do { __builtin_amdgcn_s_setprio(1); _Pragma("unroll") for (int m = 0; m < 4; ++m) _Pragma("unroll") for (int n = 0; n < 2; ++n) _Pragma("unroll") for (int k = 0; k < 2; ++k) \
        acc[ai][bj][m][n] = __builtin_amdgcn_mfma_f32_16x16x32_bf16(Bt[n][k], At[m][k], acc[ai][bj][m][n], 0, 0, 0); __builtin_amdgcn_s_setprio(0); } while (0)
#define PG8_WAIT_V(n) asm volatile("s_waitcnt vmcnt(" #n ")" ::: "memory")
#define PG8_WAIT_L(n) asm volatile("s_waitcnt lgkmcnt(" #n ")" ::: "memory")
#define PG8_BAR __builtin_amdgcn_s_barrier()
#define PG8_SCHED __builtin_amdgcn_sched_barrier(0)
    Unit cur, nxt; int ui = 0;
    if (!S.next(0, cur)) return;
    f32x4 acc[2][2][4][2];
#pragma unroll
    for (int a = 0; a < 2; ++a)
#pragma unroll
        for (int b = 0; b < 2; ++b)
#pragma unroll
            for (int m = 0; m < 4; ++m)
#pragma unroll
                for (int n = 0; n < 2; ++n) acc[a][b][m][n] = (f32x4){0.f, 0.f, 0.f, 0.f};
    bf16x8 At[4][2], B0[2][2], B1[2][2];
    const char* cA = GATHER ? (const char*)g.A : (const char*)g.A + (size_t)cur.z * g.zsA + (size_t)cur.pm * tstep; const char* cB = (const char*)g.Bt + (size_t)cur.z * g.zsB + (size_t)cur.pn * tstep;
    const size_t hA = GATHER ? 0 : hstep;
    if (GATHER) { PG8_GLOAD(gA, cur); } else { gA[0][0] = voffA[0]; gA[0][1] = voffA[1]; gA[1][0] = voffA[0]; gA[1][1] = voffA[1]; }
#pragma unroll
    for (int h = 0; h < 2; ++h) { gN[h][0] = gA[h][0]; gN[h][1] = gA[h][1]; }
    PG8_STAGE(PG8_SB(0, 0), cB, voffB); PG8_STAGE(PG8_SB(0, 1), cB + hstep, voffB); PG8_STAGE(PG8_SA(0, 0), cA, gA[0]); PG8_STAGE(PG8_SA(0, 1), cA + hA, gA[1]);
    if (wr == 1) PG8_BAR;
    PG8_WAIT_V(2); PG8_BAR;
    PG8_STAGE(PG8_SB(1, 0), cB + kstep, voffB); PG8_STAGE(PG8_SA(1, 0), cA + kstep, gA[0]); PG8_STAGE(PG8_SB(1, 1), cB + hstep + kstep, voffB);
    PG8_WAIT_V(6); PG8_BAR;
    for (;;) {
        const bool has_next = S.next(ui + 1, nxt);
        if (GATHER && has_next) { PG8_GLOAD(gN, nxt); }
        const char* nA = GATHER ? cA : (has_next ? (const char*)g.A + (size_t)nxt.z * g.zsA + (size_t)nxt.pm * tstep : cA); const char* nB = has_next ? (const char*)g.Bt + (size_t)nxt.z * g.zsB + (size_t)nxt.pn * tstep : cB;
        for (int t = 0; t < nt; t += 2) {
            const bool last = (t == nt - 2);
            const char* a1 = cA + (size_t)(t + 1) * kstep;
            const char* a2 = last ? nA : cA + (size_t)(t + 2) * kstep; const char* b2 = last ? nB : cB + (size_t)(t + 2) * kstep;
            const char* a3 = a2 + kstep; const char* b3 = b2 + kstep;
            unsigned s0[2], s1[2];
            s0[0] = last ? gN[0][0] : gA[0][0]; s0[1] = last ? gN[0][1] : gA[0][1]; s1[0] = last ? gN[1][0] : gA[1][0]; s1[1] = last ? gN[1][1] : gA[1][1];
            PG8_LDB(B0, 0, 0); PG8_LDB(B1, 0, 1); PG8_SCHED; PG8_LDA(At, 0, 0); PG8_STAGE(PG8_SA(1, 1), a1 + hA, gA[1]);
            PG8_WAIT_V(8); PG8_WAIT_L(0); PG8_BAR; PG8_MMA(0, 0, At, B0); PG8_MMA(0, 1, At, B1); PG8_BAR; PG8_SCHED;
            PG8_LDA(At, 0, 1); PG8_STAGE(PG8_SB(0, 0), b2, voffB); PG8_STAGE(PG8_SB(0, 1), b2 + hstep, voffB); PG8_STAGE(PG8_SA(0, 0), a2, s0);
            PG8_WAIT_V(8); PG8_WAIT_L(0); PG8_BAR; PG8_MMA(1, 0, At, B0); PG8_MMA(1, 1, At, B1); PG8_BAR; PG8_SCHED;
            PG8_LDB(B0, 1, 0); PG8_LDB(B1, 1, 1); PG8_SCHED; PG8_LDA(At, 1, 0); PG8_STAGE(PG8_SA(0, 1), a2 + hA, s1);
            PG8_WAIT_V(8); PG8_WAIT_L(0); PG8_BAR; PG8_MMA(0, 0, At, B0); PG8_MMA(0, 1, At, B1); PG8_BAR; PG8_SCHED;
            PG8_LDA(At, 1, 1); PG8_STAGE(PG8_SB(1, 0), b3, voffB); PG8_STAGE(PG8_SB(1, 1), b3 + hstep, voffB); PG8_STAGE(PG8_SA(1, 0), a3, s0);
            PG8_WAIT_V(8); PG8_WAIT_L(0); PG8_BAR; PG8_MMA(1, 0, At, B0); PG8_MMA(1, 1, At, B1); PG8_BAR; PG8_SCHED;
        }
        if (wr == 0) PG8_BAR;
        E(acc, cur, wr, wc, fr, fq);
        if (!has_next) break;
        if (!E.keep(cur))
#pragma unroll
        for (int a = 0; a < 2; ++a)
#pragma unroll
            for (int b = 0; b < 2; ++b)
#pragma unroll
                for (int m = 0; m < 4; ++m)
#pragma unroll
                    for (int n = 0; n < 2; ++n) acc[a][b][m][n] = (f32x4){0.f, 0.f, 0.f, 0.f};
        cur = nxt; cA = nA; cB = nB; ++ui;
#pragma unroll
        for (int h = 0; h < 2; ++h) { gA[h][0] = gN[h][0]; gA[h][1] = gN[h][1]; }
        if (wr == 1) PG8_BAR;
    }
    PG8_WAIT_V(0);
    PG8_BAR;
#undef PG8_SA
#undef PG8_SB
#undef PG8_STAGE
#undef PG8_GLOAD
#undef PG8_LDA
#undef PG8_LDB
#undef PG8_MMA
#undef PG8_WAIT_V
#undef PG8_WAIT_L
#undef PG8_BAR
#undef PG8_SCHED
}
}

constexpr int SEQ = 16384, DM = 1024, NL = 4;
constexpr int NPROJ = 5120;
constexpr int C_Z = 0, C_XBC = 512, C_SBQKV = 1536, C_GQKV = 3072, C_GGATE = 4608, C_BRG = 5120;
constexpr int IN_COLS = 8208;
constexpr float EPS = 1e-6f;
constexpr int NSLOT = 40960;
constexpr int NWAVES = 8;

constexpr size_t MiB = 1u << 20;
constexpr size_t WS_CTL = 0, CTL_ZERO_BYTES = 1 * MiB;
constexpr size_t WS_MODP = 1 * MiB;
constexpr size_t WS_MODF = 1 * MiB + 896 * 1024;
constexpr size_t WS_WSM = 2 * MiB;
constexpr size_t WS_WRT = 3 * MiB;
constexpr size_t WS_PAIR = 4 * MiB;
constexpr size_t WS_TOKOF = 580 * MiB;
constexpr size_t WS_SMALL = 5 * MiB;
constexpr size_t WS_WIN = 8 * MiB;
constexpr size_t WS_WBR = 72 * MiB;
constexpr size_t WS_WOUT = 84 * MiB;
constexpr size_t WS_WGU = 92 * MiB;
constexpr size_t WS_WD = 348 * MiB;
constexpr size_t WS_HB = 476 * MiB;
constexpr size_t WS_YBR = 508 * MiB;
constexpr size_t WS_PROJ = 620 * MiB;
constexpr size_t WS_GATES = 780 * MiB;
constexpr size_t WS_ACT = 700 * MiB;
constexpr size_t WS_YP = 740 * MiB;
constexpr size_t WS_MERGED = 940 * MiB;
constexpr size_t WS_XBCB = 876 * MiB;
constexpr size_t WS_SST = 908 * MiB;
constexpr size_t WS_SHIN = 556 * MiB;
constexpr size_t WS_ACUM = 572 * MiB;
constexpr size_t WS_SDEC = 573 * MiB;
constexpr size_t WS_GQE = 588 * MiB;
constexpr size_t WS_GOU = 604 * MiB;
constexpr size_t WS_GAP = 940 * MiB;
constexpr size_t WS_GBT = 972 * MiB;
constexpr size_t WS_GST = 1004 * MiB;
constexpr size_t WS_GDEC = 7 * MiB + 512 * 1024;
constexpr size_t WS_GAP2 = 574 * MiB;
constexpr size_t WS_GBT2 = 576 * MiB;
constexpr size_t WS_GST2 = 578 * MiB;
constexpr size_t WS_END = 1036 * MiB;
constexpr int CW_TMO = 0;
constexpr int CW_BAR = 4096;
constexpr int CW_SBQ = 190000;
constexpr int CW_CNT = 200000;
constexpr int N_PHASES = 54;

constexpr int LDS_BYTES = 151552;
constexpr int MISC_OFF = 147456;

#define GAS __attribute__((address_space(1)))
#define LAS __attribute__((address_space(3)))
typedef unsigned short bf16;
typedef unsigned v4u __attribute__((ext_vector_type(4)));
typedef unsigned v2u __attribute__((ext_vector_type(2)));
typedef float f32x4 __attribute__((ext_vector_type(4)));
typedef float f32x2 __attribute__((ext_vector_type(2)));
__device__ __forceinline__ unsigned f2bf(float f) { unsigned u = __builtin_bit_cast(unsigned, f); return (u + 0x7fffu + ((u >> 16) & 1u)) >> 16; }
__device__ __forceinline__ unsigned pk2(float lo, float hi) { return f2bf(lo) | (f2bf(hi) << 16); }
__device__ __forceinline__ float bflo(unsigned u) { return __uint_as_float(u << 16); }
__device__ __forceinline__ float bfhi(unsigned u) { return __uint_as_float(u & 0xffff0000u); }
__device__ __forceinline__ void unpack8(const v4u u, float* f) { f[0] = bflo(u.x); f[1] = bfhi(u.x); f[2] = bflo(u.y); f[3] = bfhi(u.y); f[4] = bflo(u.z); f[5] = bfhi(u.z); f[6] = bflo(u.w); f[7] = bfhi(u.w); }
__device__ __forceinline__ float silu_f(float x) { return x * __builtin_amdgcn_rcpf(1.0f + __expf(-x)); }
__device__ __forceinline__ float sigmoid_f(float x) { return __builtin_amdgcn_rcpf(1.0f + __expf(-x)); }
__device__ __forceinline__ float softplus_f(float x) { return fmaxf(x, 0.f) + log1pf(__expf(-fabsf(x))); }
__device__ __forceinline__ float wave_sum(float v) {
#pragma unroll
    for (int o = 1; o < 64; o <<= 1) v += __shfl_xor(v, o);
    return v;
}

#define XB_TMO      128
#define XB_XCNT(j)  (256  + 64 * (j))
#define XB_XSUB(j)  (1280 + 64 * (j))
#define XB_XGEN(j)  (2304 + 64 * (j))
#define XB_TOP      3328
#define XB_TOPGEN   3392
#define XCD_BAR_WORDS 3456
#define XB_SPIN_CAP (1u << 18)
__device__ __forceinline__ unsigned xb_ld(unsigned* p)              { return __hip_atomic_load(p, __ATOMIC_RELAXED, __HIP_MEMORY_SCOPE_AGENT); }
__device__ __forceinline__ unsigned xb_add(unsigned* p, unsigned v) { return __hip_atomic_fetch_add(p, v, __ATOMIC_RELAXED, __HIP_MEMORY_SCOPE_AGENT); }
__device__ __forceinline__ unsigned xb_xcc_id() { return (unsigned)__builtin_amdgcn_s_getreg((3 << 11) | 20) & 0xFu; }
#define XB_SPIN(cond, bar) do { unsigned _sp = 0; while (cond) { __builtin_amdgcn_s_sleep(1); \
    if ((++_sp & 255u) == 0u) { if (xb_ld(&(bar)[XB_TMO])) break; if (_sp > XB_SPIN_CAP) { atomicAdd(&(bar)[XB_TMO], 1u); break; } } } } while (0)
struct XcdBarrier { unsigned* bar; unsigned x; volatile LAS unsigned* st; };
__device__ __forceinline__ XcdBarrier xcd_barrier_post(unsigned* bar, volatile LAS unsigned* st) {
    XcdBarrier b; b.bar = bar; b.x = xb_xcc_id(); b.st = st;
    if (threadIdx.x == 0) (void)xb_add(&bar[XB_XCNT(b.x)], 1u);
    return b;
}
__device__ __forceinline__ void xcd_barrier_complete(unsigned* bar, unsigned x, unsigned& nloc, unsigned& nx) {
    const unsigned G = gridDim.x * gridDim.y * gridDim.z;
    unsigned sum, cnt, mine, sp = 0u;
    for (;;) {
        sum = 0u; cnt = 0u; mine = 0u;
#pragma unroll
        for (unsigned j = 0; j < 16; ++j) { const unsigned c = xb_ld(&bar[XB_XCNT(j)]); sum += c; cnt += (c > 0u) ? 1u : 0u; mine = (j == x) ? c : mine; }
        if (sum == G) break;
        __builtin_amdgcn_s_sleep(1);
        if ((++sp & 255u) == 0u) { if (xb_ld(&bar[XB_TMO])) break; if (sp > XB_SPIN_CAP) { atomicAdd(&bar[XB_TMO], 1u); break; } }
    }
    nloc = mine > 0u ? mine : 1u; nx = cnt > 0u ? cnt : 1u;
}
__device__ __forceinline__ void xcd_barrier(const XcdBarrier& b) {
    asm volatile("s_waitcnt vmcnt(0)" ::: "memory");
    __syncthreads();
    if (threadIdx.x == 0) {
        unsigned* bar = b.bar;
        __builtin_amdgcn_s_waitcnt(0);
        unsigned nloc = b.st[0], nx = b.st[1];
        if (nloc == 0u) { xcd_barrier_complete(bar, b.x, nloc, nx); b.st[0] = nloc; b.st[1] = nx; }
        const unsigned old = xb_add(&bar[XB_XSUB(b.x)], 1u);
        const unsigned gen = old / nloc;
        if (old + 1u == (gen + 1u) * nloc) {
            __builtin_amdgcn_fence(__ATOMIC_RELEASE, "agent");
            asm volatile("s_waitcnt vmcnt(0)" ::: "memory");
            const unsigned og = xb_add(&bar[XB_TOP], 1u);
            const unsigned tg = og / nx;
            if (og + 1u == (tg + 1u) * nx) xb_add(&bar[XB_TOPGEN], 1u);
            else XB_SPIN(xb_ld(&bar[XB_TOPGEN]) == tg, bar);
            __builtin_amdgcn_fence(__ATOMIC_ACQUIRE, "agent");
            xb_add(&bar[XB_XGEN(b.x)], 1u);
            asm volatile("s_waitcnt vmcnt(0)" ::: "memory");
        } else {
            XB_SPIN(xb_ld(&bar[XB_XGEN(b.x)]) == gen, bar);
            __builtin_amdgcn_fence(__ATOMIC_ACQUIRE, "agent");
            asm volatile("s_waitcnt vmcnt(0)" ::: "memory");
        }
    }
    __syncthreads();
}

struct Frame {
    LAS unsigned char* lds;
    unsigned* ctl;
    int tid, lane, wave, vcu, G;
    const float* const* in;
    float* out;
    unsigned char* ws;
};
#define P_x F.in[0]
#define P_c F.in[1]
#define P_w_ada F.in[2]
#define P_b_ada F.in[3]
#define P_norm_mix F.in[4]
#define P_norm_ffn F.in[5]
#define P_w_in F.in[6]
#define P_ssm_conv_w F.in[7]
#define P_ssm_conv_b F.in[8]
#define P_ssm_dt_bias F.in[9]
#define P_ssm_a_log F.in[10]
#define P_ssm_d F.in[11]
#define P_ssm_norm F.in[12]
#define P_sb_q_norm F.in[13]
#define P_sb_k_norm F.in[14]
#define P_gdn_conv_w F.in[15]
#define P_gdn_a_log F.in[16]
#define P_gdn_dt_bias F.in[17]
#define P_gdn_norm F.in[18]
#define P_w_branch F.in[19]
#define P_w_out F.in[20]
#define P_w_group F.in[21]
#define P_b_group F.in[22]
#define P_w_router F.in[23]
#define P_b_router F.in[24]
#define P_w_gate F.in[25]
#define P_w_up F.in[26]
#define P_w_down F.in[27]
#define W_MODP ((float*)(F.ws + WS_MODP))
#define W_MODF ((float*)(F.ws + WS_MODF))
#define W_WSM ((float*)(F.ws + WS_WSM))
#define W_WRT ((float*)(F.ws + WS_WRT))
#define W_SMALL ((float*)(F.ws + WS_SMALL))
#define W_TOKOF ((int*)(F.ws + WS_TOKOF))
#define W_PAIRE ((int*)(F.ws + WS_PAIR))
#define W_PAIRS ((int*)(F.ws + WS_PAIR + 131072))
#define W_PAIRW ((float*)(F.ws + WS_PAIR + 262144))
#define W_WIN ((bf16*)(F.ws + WS_WIN))
#define W_WBR ((bf16*)(F.ws + WS_WBR))
#define W_WOUT ((bf16*)(F.ws + WS_WOUT))
#define W_WGU ((bf16*)(F.ws + WS_WGU))
#define W_WD ((bf16*)(F.ws + WS_WD))
#define W_HB ((bf16*)(F.ws + WS_HB))
#define W_YBR ((bf16*)(F.ws + WS_YBR))
#define W_PROJ ((bf16*)(F.ws + WS_PROJ))
#define W_GATES ((bf16*)(F.ws + WS_GATES))
#define W_ACT ((bf16*)(F.ws + WS_ACT))
#define W_YP ((bf16*)(F.ws + WS_YP))
#define W_MERGED ((bf16*)(F.ws + WS_MERGED))
#define W_XBCB ((bf16*)(F.ws + WS_XBCB))
#define W_SST ((float*)(F.ws + WS_SST))
#define W_SHIN ((bf16*)(F.ws + WS_SHIN))
#define W_ACUM ((float*)(F.ws + WS_ACUM))
#define W_SDEC ((float*)(F.ws + WS_SDEC))
#define W_GQE ((bf16*)(F.ws + WS_GQE))
#define W_GOU ((bf16*)(F.ws + WS_GOU))
#define W_GAP ((bf16*)(F.ws + WS_GAP))
#define W_GBT ((bf16*)(F.ws + WS_GBT))
#define W_GST ((bf16*)(F.ws + WS_GST))
#define W_GDEC ((float*)(F.ws + WS_GDEC))
#define W_GAP2 ((bf16*)(F.ws + WS_GAP2))
#define W_GBT2 ((bf16*)(F.ws + WS_GBT2))
#define W_GST2 ((bf16*)(F.ws + WS_GST2))


template <bool FIN>
__device__ __forceinline__ f32x4 modv4(const Frame& F, int l, int seg, int col) {
    const int o = l * 6144 + seg * 1024 + col;
    f32x4 a;
    if (FIN) a = *(const f32x4*)(W_MODF + o);
    else { a = *(const f32x4*)(P_b_ada + o);
#pragma unroll
        for (int k = 0; k < 8; ++k) a += *(const f32x4*)(W_MODP + (size_t)k * 24576 + o); }
    asm volatile("" : "+v"(a) :: "memory");
    return a;
}

__device__ __forceinline__ void transpose_item(const float* W, int ldw, bf16* WT, int ldt, int k0, LAS float* scr, int lane) {
    float tv[32];
#pragma unroll
    for (int i = 0; i < 32; ++i) tv[i] = W[(size_t)(k0 + 2 * i + (lane >> 5)) * ldw + (lane & 31)];
#pragma unroll
    for (int i = 0; i < 32; ++i) scr[(2 * i + (lane >> 5)) * 33 + (lane & 31)] = tv[i];
    asm volatile("s_waitcnt lgkmcnt(0)" ::: "memory");
    const int c = lane & 7;
#pragma unroll
    for (int j = 0; j < 4; ++j) { const int n = (lane >> 3) + 8 * j; const LAS float* s = scr + (8 * c) * 33 + n;
        v4u o; o.x = pk2(s[0 * 33], s[1 * 33]); o.y = pk2(s[2 * 33], s[3 * 33]); o.z = pk2(s[4 * 33], s[5 * 33]); o.w = pk2(s[6 * 33], s[7 * 33]);
        *(v4u*)(WT + (size_t)n * ldt + k0 + 8 * c) = o; }
    asm volatile("s_waitcnt lgkmcnt(0)" ::: "memory");
}
__device__ __forceinline__ void p0_prologue(Frame& F) {
    LAS float* scr = (LAS float*)(F.lds + F.wave * 16384);
    const int gw = F.vcu * NWAVES + F.wave, NGW = F.G * NWAVES, lane = F.lane;
    constexpr int N_MOD = 768, N_WIN = 16384, N_BR = 3072, N_OUT = 2048, N_GU = 65536, N_DN = 32768;
    for (int it = gw; it < N_MOD + N_WIN + N_BR + N_OUT + N_GU + N_DN; it += NGW) {
        int r = it;
        if (r < N_MOD) {
            const int l = r / 192, rr = r % 192, cg = rr >> 3, kc = rr & 7, col = cg * 256 + 4 * lane;
            const float* w = P_w_ada + ((size_t)l * 1024 + kc * 128) * 6144 + col; f32x4 acc = (f32x4){0.f, 0.f, 0.f, 0.f};
#pragma unroll 8
            for (int k = 0; k < 128; ++k) { const float cv = P_c[kc * 128 + k]; acc += silu_f(cv) * *(const f32x4*)(w + (size_t)k * 6144); }
            *(f32x4*)(W_MODP + (size_t)kc * 24576 + l * 6144 + col) = acc; continue; }
        r -= N_MOD;
        if (r < N_WIN) { const int l = r >> 12, q = r & 4095, kb = q >> 8, nb = q & 255, n0 = 32 * nb, sh = n0 < 1536 ? 0 : (n0 < 4608 ? 8 : 16);
            transpose_item(P_w_in + (size_t)l * 1024 * IN_COLS + n0 + sh, IN_COLS, W_WIN + ((size_t)l * 8192 + n0) * 1024, 1024, 64 * kb, scr, lane); continue; }
        r -= N_WIN;
        if (r < N_BR) { const int idx = r >> 8, q = r & 255, kb = q >> 5, nb = q & 31;
            transpose_item(P_w_branch + (size_t)idx * 512 * 1024 + 32 * nb, 1024, W_WBR + ((size_t)idx * 1024 + 32 * nb) * 512, 512, 64 * kb, scr, lane); continue; }
        r -= N_BR;
        if (r < N_OUT) { const int l = r >> 9, q = r & 511, kb = q >> 5, nb = q & 31;
            transpose_item(P_w_out + (size_t)l * 1024 * 1024 + 32 * nb, 1024, W_WOUT + ((size_t)l * 1024 + 32 * nb) * 1024, 1024, 64 * kb, scr, lane); continue; }
        r -= N_OUT;
        if (r < N_GU) { const int idx = r >> 8, le = idx >> 1, up = idx & 1, q = r & 255, kb = q >> 4, nb = q & 15, n0 = 32 * nb, drow = (n0 >> 7) * 256 + (n0 & 127) + up * 128;
            transpose_item((up ? P_w_up : P_w_gate) + (size_t)le * 1024 * 512 + n0, 512, W_WGU + ((size_t)le * 1024 + drow) * 1024, 1024, 64 * kb, scr, lane); continue; }
        r -= N_GU;
        { const int le = r >> 8, q = r & 255, kb = q >> 5, nb = q & 31;
            transpose_item(P_w_down + (size_t)le * 512 * 1024 + 32 * nb, 1024, W_WD + ((size_t)le * 1024 + 32 * nb) * 512, 512, 64 * kb, scr, lane); }
    }
    const int gt = F.vcu * 512 + F.tid, NGT = F.G * 512;
    for (int i = gt; i < NL * 16 * 1024; i += NGT) { const int l = i >> 14, j = (i >> 10) & 15, k = i & 1023; const int oc = j < 8 ? 1536 + j : 4616 + (j - 8);
        W_WSM[i] = P_w_in[((size_t)l * 1024 + k) * IN_COLS + oc]; }
    for (int i = gt; i < NL * 36 * 1024; i += NGT) { const int l = i / 36864, q = i % 36864, j = q >> 10, k = q & 1023;
        W_WRT[i] = j < 4 ? P_w_group[((size_t)l * 1024 + k) * 4 + j] : P_w_router[((size_t)l * 1024 + k) * 32 + (j - 4)]; }
}

__device__ __forceinline__ int build_tile_table(Frame& F, int l, LAS int* tab) {
    __syncthreads();
    if (F.tid < 64) {
        const unsigned cnt = F.tid < 32 ? __hip_atomic_load(F.ctl + CW_CNT + (l * 32 + (F.tid & 31)) * 64, __ATOMIC_RELAXED, __HIP_MEMORY_SCOPE_AGENT) : 0u;
        int nt = (int)((cnt + 255u) >> 8), inc = nt;
#pragma unroll
        for (int o = 1; o < 32; o <<= 1) { const int v = __shfl_up(inc, o); if (F.lane >= o) inc += v; }
        if (F.tid < 32) { tab[F.tid] = inc - nt; tab[64 + F.tid] = (int)cnt; }
        if (F.tid == 31) tab[32] = inc; }
    __syncthreads();
    return tab[32];
}

#define TR_STEP(HALF, OFF) { const bool hi_ = (lane & (OFF)) != 0; _Pragma("unroll") for (int i_ = 0; i_ < (HALF); ++i_) { \
        const float snd_ = hi_ ? v[i_] : v[(HALF) + i_]; const float kp_ = hi_ ? v[(HALF) + i_] : v[i_]; v[i_] = kp_ + __shfl_xor(snd_, (OFF)); } }
__device__ __forceinline__ float treduce16(float (&v)[16], int lane) { TR_STEP(8, 32) TR_STEP(4, 16) TR_STEP(2, 8) TR_STEP(1, 4) float r = v[0]; r += __shfl_xor(r, 2); r += __shfl_xor(r, 1); return r; }
__device__ __forceinline__ float treduce32(float (&v)[32], int lane) { TR_STEP(16, 32) TR_STEP(8, 16) TR_STEP(4, 8) TR_STEP(2, 4) TR_STEP(1, 2) float r = v[0]; r += __shfl_xor(r, 1); return r; }
__device__ __forceinline__ float treduce4(float (&v)[4], int lane) { TR_STEP(2, 32) TR_STEP(1, 16) float r = v[0]; r += __shfl_xor(r, 8); r += __shfl_xor(r, 4); r += __shfl_xor(r, 2); r += __shfl_xor(r, 1); return r; }
#undef TR_STEP
constexpr int GRPW_OFF = 131072;
template <bool FFN>
__device__ __forceinline__ void phase_norm(Frame& F, int l) {
    const int lane = F.lane, gw = F.vcu * NWAVES + F.wave, NGW = F.G * NWAVES;
    const bool comb = (!FFN) && l > 0;
    LAS float* WL = (LAS float*)F.lds; LAS float* WG = (LAS float*)(F.lds + GRPW_OFF);
    if (!FFN) { const f32x4* s = (const f32x4*)(W_WSM + (size_t)l * 16 * 1024); for (int i = F.tid; i < 4096; i += 512) ((LAS f32x4*)WL)[i] = s[i]; }
    else { const f32x4* s = (const f32x4*)(W_WRT + (size_t)l * 36 * 1024); for (int i = F.tid; i < 8192; i += 512) ((LAS f32x4*)WL)[i] = s[1024 + i];
           for (int i = F.tid; i < 1024; i += 512) ((LAS f32x4*)WG)[i] = s[i]; }
    f32x4 A4[4], B4[4], G4[4];
    const float* ng = (FFN ? P_norm_ffn : P_norm_mix) + l * 1024;
#pragma unroll
    for (int j = 0; j < 4; ++j) { const int col = j * 256 + 4 * lane; const f32x4 g = *(const f32x4*)(ng + col);
        f32x4 sh, sc;
        if (!FFN && l == 0) { sh = modv4<false>(F, l, 0, col); sc = modv4<false>(F, l, 1, col); }
        else { sh = modv4<true>(F, l, FFN ? 3 : 0, col); sc = modv4<true>(F, l, FFN ? 4 : 1, col); }
        A4[j] = g * (sc + 1.0f); B4[j] = sh; G4[j] = comb ? modv4<true>(F, l - 1, 5, col) : (f32x4){0.f, 0.f, 0.f, 0.f}; }
    const float* xin = (!FFN && l == 0) ? P_x : F.out;
    LAS int* ttab = (LAS int*)(F.lds + MISC_OFF + 3072);
    if (comb) build_tile_table(F, l - 1, ttab);
    float be = 0.f, bg = 0.f;
    LAS int* lcnt = (LAS int*)(F.lds + MISC_OFF + 2048); LAS int* lbase = lcnt + 32;
    if (FFN) { be = P_b_router[l * 32 + ((lane >> 1) & 31)]; bg = P_b_group[l * 4 + ((lane >> 4) & 3)]; if (F.tid < 32) lcnt[F.tid] = 0; }
    __syncthreads();
    for (int m0 = 2 * gw; m0 < SEQ; m0 += 2 * NGW) {
        f32x4 v[2][4];
#pragma unroll
        for (int r = 0; r < 2; ++r)
#pragma unroll
            for (int j = 0; j < 4; ++j) v[r][j] = ((const f32x4*)(xin + (size_t)(m0 + r) * 1024))[64 * j + lane];
        if (comb) {
#pragma unroll
            for (int r = 0; r < 2; ++r) { const int m = m0 + r;
                const int s0 = ttab[W_PAIRE[2 * m]] * 256 + W_PAIRS[2 * m], s1 = ttab[W_PAIRE[2 * m + 1]] * 256 + W_PAIRS[2 * m + 1]; const float w0 = W_PAIRW[2 * m], w1 = W_PAIRW[2 * m + 1];
                const v2u* y0 = (const v2u*)(W_YP + (size_t)s0 * 1024); const v2u* y1 = (const v2u*)(W_YP + (size_t)s1 * 1024);
#pragma unroll
                for (int j = 0; j < 4; ++j) { const v2u a = y0[64 * j + lane], b = y1[64 * j + lane];
                    f32x4 y; y[0] = w0 * bflo(a.x) + w1 * bflo(b.x); y[1] = w0 * bfhi(a.x) + w1 * bfhi(b.x); y[2] = w0 * bflo(a.y) + w1 * bflo(b.y); y[3] = w0 * bfhi(a.y) + w1 * bfhi(b.y);
                    v[r][j] += G4[j] * y; ((f32x4*)(F.out + (size_t)m * 1024))[64 * j + lane] = v[r][j]; } }
        }
        float ss[2];
#pragma unroll
        for (int r = 0; r < 2; ++r) { float s = 0.f;
#pragma unroll
            for (int j = 0; j < 4; ++j) s += (v[r][j][0] * v[r][j][0] + v[r][j][1] * v[r][j][1]) + (v[r][j][2] * v[r][j][2] + v[r][j][3] * v[r][j][3]);
            ss[r] = s; }
#pragma unroll
        for (int o = 1; o < 64; o <<= 1) { ss[0] += __shfl_xor(ss[0], o); ss[1] += __shfl_xor(ss[1], o); }
#pragma unroll
        for (int r = 0; r < 2; ++r) { const float rstd = rsqrtf(ss[r] * (1.0f / 1024.0f) + EPS);
#pragma unroll
            for (int j = 0; j < 4; ++j) { v[r][j] = v[r][j] * rstd * A4[j] + B4[j];
                v2u o; o.x = pk2(v[r][j][0], v[r][j][1]); o.y = pk2(v[r][j][2], v[r][j][3]); ((v2u*)(W_HB + (size_t)(m0 + r) * 1024))[64 * j + lane] = o; } }
        if (!FFN) {
            float a0[16], a1[16]; const LAS float* wl = WL + 4 * lane; asm volatile("" : "+v"(wl));
#pragma unroll
            for (int c = 0; c < 16; ++c) { f32x2 q0 = (f32x2){0.f, 0.f}, q1 = (f32x2){0.f, 0.f};
#pragma unroll
                for (int j = 0; j < 4; ++j) { const f32x4 w = *(const LAS f32x4*)(wl + c * 1024 + j * 256);
                    const f32x2 wa = (f32x2){w[0], w[1]}, wb = (f32x2){w[2], w[3]};
                    q0 += (f32x2){v[0][j][0], v[0][j][1]} * wa; q0 += (f32x2){v[0][j][2], v[0][j][3]} * wb; q1 += (f32x2){v[1][j][0], v[1][j][1]} * wa; q1 += (f32x2){v[1][j][2], v[1][j][3]} * wb; }
                a0[c] = q0.x + q0.y; a1[c] = q1.x + q1.y; if ((c & 7) == 7) asm volatile("" ::: "memory"); }
            const float r0 = treduce16(a0, lane), r1 = treduce16(a1, lane);
            if ((lane & 3) == 0) { W_SMALL[(size_t)m0 * 16 + (lane >> 2)] = r0; W_SMALL[(size_t)(m0 + 1) * 16 + (lane >> 2)] = r1; }
        } else {
            float e0[32], e1[32], g0[4], g1[4];
            const LAS float* wlo = WL + 4 * lane; const LAS float* whi = WL + 16384 + 4 * lane; const LAS float* wgl = WG + 4 * lane; asm volatile("" : "+v"(wlo), "+v"(whi), "+v"(wgl));
#pragma unroll
            for (int c = 0; c < 32; ++c) { f32x2 q0 = (f32x2){0.f, 0.f}, q1 = (f32x2){0.f, 0.f};
#pragma unroll
                for (int j = 0; j < 4; ++j) { const f32x4 w = *(const LAS f32x4*)((c < 16 ? wlo : whi) + (c & 15) * 1024 + j * 256);
                    const f32x2 wa = (f32x2){w[0], w[1]}, wb = (f32x2){w[2], w[3]};
                    q0 += (f32x2){v[0][j][0], v[0][j][1]} * wa; q0 += (f32x2){v[0][j][2], v[0][j][3]} * wb; q1 += (f32x2){v[1][j][0], v[1][j][1]} * wa; q1 += (f32x2){v[1][j][2], v[1][j][3]} * wb; }
                e0[c] = q0.x + q0.y; e1[c] = q1.x + q1.y; if ((c & 7) == 7) asm volatile("" ::: "memory"); }
#pragma unroll
            for (int c = 0; c < 4; ++c) { f32x2 q0 = (f32x2){0.f, 0.f}, q1 = (f32x2){0.f, 0.f};
#pragma unroll
                for (int j = 0; j < 4; ++j) { const f32x4 w = *(const LAS f32x4*)(wgl + c * 1024 + j * 256);
                    const f32x2 wa = (f32x2){w[0], w[1]}, wb = (f32x2){w[2], w[3]};
                    q0 += (f32x2){v[0][j][0], v[0][j][1]} * wa; q0 += (f32x2){v[0][j][2], v[0][j][3]} * wb; q1 += (f32x2){v[1][j][0], v[1][j][1]} * wa; q1 += (f32x2){v[1][j][2], v[1][j][3]} * wb; }
                g0[c] = q0.x + q0.y; g1[c] = q1.x + q1.y; }
            float xe[2], xg[2];
            xe[0] = treduce32(e0, lane) + be; xe[1] = treduce32(e1, lane) + be; xg[0] = treduce4(g0, lane) + bg; xg[1] = treduce4(g1, lane) + bg;
#pragma unroll
            for (int r = 0; r < 2; ++r) { const int m = m0 + r;
                float lgr[4];
#pragma unroll
                for (int c = 0; c < 4; ++c) lgr[c] = __shfl(xg[r], c << 4);
                int gs = 0; float gm = lgr[0];
#pragma unroll
                for (int c = 1; c < 4; ++c) if (lgr[c] > gm) { gm = lgr[c]; gs = c; }
                float den = 0.f;
#pragma unroll
                for (int c = 0; c < 4; ++c) den += __expf(lgr[c] - gm);
                const float pg = 1.0f / den;
                float lr[8];
#pragma unroll
                for (int i = 0; i < 8; ++i) lr[i] = __shfl(xe[r], (8 * gs + i) << 1);
                int i1 = 0; float m1 = lr[0];
#pragma unroll
                for (int i = 1; i < 8; ++i) if (lr[i] > m1) { m1 = lr[i]; i1 = i; }
                int i2 = -1; float m2 = -3.0e38f;
#pragma unroll
                for (int i = 0; i < 8; ++i) if (i != i1 && lr[i] > m2) { m2 = lr[i]; i2 = i; }
                const float t = __expf(m2 - m1), w1 = pg / (1.0f + t), w2 = pg * t / (1.0f + t);
                if (lane == 0) {
                    const int e1i = gs * 8 + i1, e2i = gs * 8 + i2;
                    const int p1 = __hip_atomic_fetch_add(lcnt + e1i, 1, __ATOMIC_RELAXED, __HIP_MEMORY_SCOPE_WORKGROUP), p2 = __hip_atomic_fetch_add(lcnt + e2i, 1, __ATOMIC_RELAXED, __HIP_MEMORY_SCOPE_WORKGROUP);
                    W_PAIRE[2 * m] = e1i; W_PAIRE[2 * m + 1] = e2i; W_PAIRS[2 * m] = (int)p1; W_PAIRS[2 * m + 1] = (int)p2; W_PAIRW[2 * m] = w1; W_PAIRW[2 * m + 1] = w2;
                } }
        }
    }
    if (FFN) {
        asm volatile("s_waitcnt vmcnt(0)" ::: "memory");
        __syncthreads();
        if (F.tid < 32) { const int c = lcnt[F.tid]; lbase[F.tid] = c ? (int)atomicAdd(F.ctl + CW_CNT + (l * 32 + F.tid) * 64, (unsigned)c) : 0; }
        __syncthreads();
        for (int m0 = 2 * gw; m0 < SEQ; m0 += 2 * NGW) if (lane < 4) { const int idx = 2 * m0 + lane, e = W_PAIRE[idx], pos = W_PAIRS[idx] + lbase[e];
            W_PAIRS[idx] = pos; W_TOKOF[e * 16384 + pos] = m0 + (lane >> 1); }
    }
    if (!FFN && l == 0) {
        for (int i = F.vcu * 512 + F.tid; i < NL * 6144; i += F.G * 512) { float a = P_b_ada[i];
#pragma unroll
            for (int k = 0; k < 8; ++k) a += W_MODP[(size_t)k * 24576 + i];
            W_MODF[i] = a; }
    }
    __syncthreads();
}


typedef short bf16x8 __attribute__((ext_vector_type(8)));
#define MFMA16(a, b, c) __builtin_amdgcn_mfma_f32_16x16x32_bf16(a, b, c, 0, 0, 0)
constexpr int GX_KN = 0, GX_QN = 17408, GX_LM = 34816, GX_MX = 62464, GX_TRT = 79872, GX_SC = 116736;

__device__ __forceinline__ void gdn_phase_x(Frame& F, int l) {
    LAS unsigned char* L = F.lds;
    LAS bf16* Kn = (LAS bf16*)(L + GX_KN);
    LAS bf16* Qn = (LAS bf16*)(L + GX_QN);
    LAS bf16* LM = (LAS bf16*)(L + GX_LM);
    LAS float* Mx = (LAS float*)(L + GX_MX);
    LAS bf16* TRT = (LAS bf16*)(L + GX_TRT);
    const int tid = F.tid, lane = F.lane, w = F.wave, r16 = lane & 15, kq = lane >> 4;
    const float* cw = P_gdn_conv_w + (size_t)l * 4 * 1536;
    LAS float* SC = (LAS float*)(L + GX_SC);
    for (int k = w; F.vcu + k * F.G < 1024; k += NWAVES) { const int ix = F.vcu + k * F.G, hh = ix & 3, u = hh * 256 + (ix >> 2), t0 = (u & 255) * 64; LAS float* s = SC + k * 320;
        float g = -__expf(P_gdn_a_log[l * 4 + hh]) * softplus_f(W_SMALL[(size_t)(t0 + lane) * 16 + 8 + hh] + P_gdn_dt_bias[l * 4 + hh]);
#pragma unroll
        for (int o = 1; o < 64; o <<= 1) { const float v = __shfl_up(g, o); if (lane >= o) g += v; }
        const float gl = __shfl(g, 63), b = sigmoid_f(W_SMALL[(size_t)(t0 + lane) * 16 + 12 + hh]), ga = __expf(g);
        s[lane] = g; s[64 + lane] = b; s[128 + lane] = ga; s[192 + lane] = __expf(gl - g); s[256 + lane] = b * ga;
        if (lane == 63) W_GDEC[u] = ga; }
    v4u xr[3][4][2];
#define GX_LOADX(uu, S0, S1) do { const int hh_ = (uu) >> 8, t0_ = ((uu) & 255) * 64, t_ = tid >> 3, c8_ = tid & 7; _Pragma("unroll") for (int sg_ = (S0); sg_ < (S1); ++sg_) _Pragma("unroll") for (int i_ = 0; i_ < 4; ++i_) { \
        const int ts_ = t0_ + t_ - 3 + i_; const bf16* xp_ = W_PROJ + (size_t)(ts_ < 0 ? 0 : ts_) * NPROJ + C_GQKV + sg_ * 512 + hh_ * 128 + 16 * c8_; xr[sg_][i_][0] = *(const v4u*)xp_; xr[sg_][i_][1] = *(const v4u*)(xp_ + 8); } } while (0)
    if (F.vcu < 1024) GX_LOADX((F.vcu & 3) * 256 + (F.vcu >> 2), 0, 2);
    LAS float* cwl = (LAS float*)(L + 126976);
    int hh_l = -1;
    __syncthreads();
    int kun = 0;
    const int tid_outer = tid;
    for (int ix = F.vcu; ix < 1024; ix += F.G, ++kun) {
        const int u = (ix & 3) * 256 + (ix >> 2), ixn = ix + F.G, un = (ixn & 3) * 256 + (ixn >> 2);
        if ((u >> 8) != hh_l) { hh_l = u >> 8; __syncthreads();
            for (int i = tid_outer; i < 1536; i += 512) { const int tp = i / 384, c = i % 384; cwl[i] = cw[tp * 1536 + (c >> 7) * 512 + hh_l * 128 + (c & 127)]; }
            __syncthreads(); }
        int tid_l = tid_outer; asm volatile("" : "+v"(tid_l));
        const int tid = tid_l, lane = tid & 63, r16 = lane & 15, kq = lane >> 4;
        const int hh = u >> 8, ch = u & 255, t0 = ch * 64;
        LAS float* gc = SC + kun * 320; LAS float* be = gc + 64; LAS float* gam = be + 64; LAS float* kdec = gam + 64; LAS float* bg = kdec + 64;
        { const int t = tid >> 3, c8 = tid & 7;
          GX_LOADX(u, 2, 3);
#pragma unroll
          for (int sg = 0; sg < 3; ++sg) { const int cb = sg * 512 + hh * 128 + 16 * c8; float a[16];
#pragma unroll
            for (int e = 0; e < 16; ++e) a[e] = 0.f;
#pragma unroll
            for (int i = 0; i < 4; ++i) { const int ts = t0 + t - 3 + i; const float msk = ts < 0 ? 0.f : 1.f; float xv[16]; unpack8(xr[sg][i][0], xv); unpack8(xr[sg][i][1], xv + 8);
#pragma unroll
                for (int e4 = 0; e4 < 4; ++e4) { const f32x4 wv = *(const LAS f32x4*)(cwl + i * 384 + sg * 128 + 16 * c8 + 4 * e4) * msk;
                    a[4 * e4] += wv[0] * xv[4 * e4]; a[4 * e4 + 1] += wv[1] * xv[4 * e4 + 1]; a[4 * e4 + 2] += wv[2] * xv[4 * e4 + 2]; a[4 * e4 + 3] += wv[3] * xv[4 * e4 + 3]; } }
            float ss = 0.f;
#pragma unroll
            for (int e = 0; e < 16; ++e) { a[e] = silu_f(a[e]); ss += a[e] * a[e]; }
            if (sg < 2) { ss += __shfl_xor(ss, 1); ss += __shfl_xor(ss, 2); ss += __shfl_xor(ss, 4); const float sc = rsqrtf(ss + EPS) * (sg == 0 ? 0.08838834764831845f : 1.0f);
#pragma unroll
                for (int e = 0; e < 16; ++e) a[e] *= sc; }
            if (sg == 0) { v4u o0, o1; o0.x = pk2(a[0], a[1]); o0.y = pk2(a[2], a[3]); o0.z = pk2(a[4], a[5]); o0.w = pk2(a[6], a[7]); o1.x = pk2(a[8], a[9]); o1.y = pk2(a[10], a[11]); o1.z = pk2(a[12], a[13]); o1.w = pk2(a[14], a[15]);
                *(LAS v4u*)(Qn + t * 136 + 16 * c8) = o0; *(LAS v4u*)(Qn + t * 136 + 16 * c8 + 8) = o1; }
            else if (sg == 1) { v4u o0, o1; o0.x = pk2(a[0], a[1]); o0.y = pk2(a[2], a[3]); o0.z = pk2(a[4], a[5]); o0.w = pk2(a[6], a[7]); o1.x = pk2(a[8], a[9]); o1.y = pk2(a[10], a[11]); o1.z = pk2(a[12], a[13]); o1.w = pk2(a[14], a[15]);
                *(LAS v4u*)(Kn + t * 136 + 16 * c8) = o0; *(LAS v4u*)(Kn + t * 136 + 16 * c8 + 8) = o1;
                const float kd = kdec[t], bgt = bg[t];
#pragma unroll
                for (int e = 0; e < 16; ++e) { LM[(16 * c8 + e) * 72 + t] = (bf16)f2bf(a[e] * kd); TRT[(16 * c8 + e) * 72 + t] = (bf16)f2bf(a[e] * bgt); } }
            else { const float bt = be[t];
#pragma unroll
                for (int e = 0; e < 16; ++e) TRT[(128 + 16 * c8 + e) * 72 + t] = (bf16)f2bf(a[e] * bt); }
            asm volatile("" ::: "memory"); } }
        __syncthreads();
        { const LAS bf16* Ab = (w < 4 ? Kn : Qn) + (16 * (w & 3) + r16) * 136 + 8 * kq; bf16x8 a[4];
#pragma unroll
          for (int ks = 0; ks < 4; ++ks) a[ks] = *(const LAS bf16x8*)(Ab + 32 * ks);
#pragma unroll
          for (int nt = 0; nt < 4; ++nt) { f32x4 d = (f32x4){0.f, 0.f, 0.f, 0.f};
#pragma unroll
            for (int ks = 0; ks < 4; ++ks) { const bf16x8 b = *(const LAS bf16x8*)(Kn + (16 * nt + r16) * 136 + 32 * ks + 8 * kq); d = MFMA16(a[ks], b, d); }
            const int jt = 16 * nt + r16; const float gj = gc[jt];
#pragma unroll
            for (int j = 0; j < 4; ++j) { const int i = 16 * (w & 3) + 4 * kq + j; const float e = __expf(gc[i] - gj);
                if (w < 4) Mx[jt * 68 + i] = (jt < i) ? be[i] * d[j] * e : 0.f;
                else LM[(128 + i) * 72 + jt] = (bf16)f2bf((jt <= i) ? d[j] * e : 0.f); } } }
        __syncthreads();
        if (ixn < 1024) GX_LOADX(un, 0, 2);
        if (w < 4) { LAS bf16* row = TRT + (64 * w + lane) * 72;
            const LAS float* Mto = Mx; asm volatile("" : "+v"(Mto));
#pragma unroll 1
            for (int rb = 0; rb < 4; ++rb) {
                float acc[16];
                unpack8(*(const LAS v4u*)(row + 16 * rb), acc); unpack8(*(const LAS v4u*)(row + 16 * rb + 8), acc + 8);
#pragma unroll 1
                for (int j8 = 0; j8 < 2 * rb; ++j8) {
                    float xv[8]; unpack8(*(const LAS v4u*)(row + 8 * j8), xv);
                    const LAS float* mp = Mto + (8 * j8) * 68 + 16 * rb;
                    f32x4 mc[2][4], mn[2][4];
#pragma unroll
                    for (int e = 0; e < 2; ++e)
#pragma unroll
                        for (int q = 0; q < 4; ++q) mc[e][q] = *(const LAS f32x4*)(mp + e * 68 + 4 * q);
#pragma unroll
                    for (int p = 0; p < 4; ++p) {
                        if (p < 3) {
#pragma unroll
                            for (int e = 0; e < 2; ++e)
#pragma unroll
                                for (int q = 0; q < 4; ++q) mn[e][q] = *(const LAS f32x4*)(mp + (2 * p + 2 + e) * 68 + 4 * q); }
                        asm volatile("" ::: "memory");
#pragma unroll
                        for (int e = 0; e < 2; ++e)
#pragma unroll
                            for (int q = 0; q < 4; ++q)
#pragma unroll
                                for (int k = 0; k < 4; ++k) acc[4 * q + k] -= mc[e][q][k] * xv[2 * p + e];
#pragma unroll
                        for (int e = 0; e < 2; ++e)
#pragma unroll
                            for (int q = 0; q < 4; ++q) mc[e][q] = mn[e][q]; } }
#pragma unroll
                for (int jj = 0; jj < 15; ++jj) { const LAS float* mp = Mto + (16 * rb + jj) * 68 + 16 * rb;
#pragma unroll
                    for (int q = (jj + 1) / 4; q < 4; ++q) { const f32x4 m = *(const LAS f32x4*)(mp + 4 * q);
#pragma unroll
                        for (int k = 0; k < 4; ++k) if (4 * q + k > jj) acc[4 * q + k] -= m[k] * acc[jj]; }
                    if (jj & 1) asm volatile("" ::: "memory"); }
                v4u o0, o1; o0.x = pk2(acc[0], acc[1]); o0.y = pk2(acc[2], acc[3]); o0.z = pk2(acc[4], acc[5]); o0.w = pk2(acc[6], acc[7]);
                o1.x = pk2(acc[8], acc[9]); o1.y = pk2(acc[10], acc[11]); o1.z = pk2(acc[12], acc[13]); o1.w = pk2(acc[14], acc[15]);
                *(LAS v4u*)(row + 16 * rb) = o0; *(LAS v4u*)(row + 16 * rb + 8) = o1; } }
        __syncthreads();
        { bf16x8 bfr[2][2];
#pragma unroll
          for (int n2 = 0; n2 < 2; ++n2)
#pragma unroll
            for (int ks = 0; ks < 2; ++ks) bfr[n2][ks] = *(const LAS bf16x8*)(TRT + (16 * (2 * w + n2) + r16) * 72 + 32 * ks + 8 * kq);
          bf16* AP = W_GAP + (size_t)u * 16384; bf16* BT = W_GBT + (size_t)u * 16384; bf16* QE = W_GQE + (size_t)u * 8192; bf16* OU = W_GOU + (size_t)u * 8192;
#pragma unroll 1
          for (int mt = 0; mt < 8; ++mt) { bf16x8 af[2];
#pragma unroll
            for (int ks = 0; ks < 2; ++ks) af[ks] = *(const LAS bf16x8*)(LM + (16 * mt + r16) * 72 + 32 * ks + 8 * kq);
#pragma unroll
            for (int n2 = 0; n2 < 2; ++n2) { const int nt = 2 * w + n2; f32x4 d = (f32x4){0.f, 0.f, 0.f, 0.f};
                if (w >= 4) {
#pragma unroll
                    for (int ks = 0; ks < 2; ++ks) d = MFMA16(af[ks], bfr[n2][ks], d);
                    v2u o; o.x = pk2(d[0], d[1]); o.y = pk2(d[2], d[3]);
                    *(v2u*)(BT + (((nt - 8) * 4 + (mt >> 1)) * 64 + lane) * 8 + 4 * (mt & 1)) = o;
                } else {
#pragma unroll
                    for (int ks = 0; ks < 2; ++ks) d = MFMA16(bfr[n2][ks], af[ks], d);
                    v2u o; o.x = pk2(-d[0], -d[1]); o.y = pk2(-d[2], -d[3]);
                    *(v2u*)(AP + (((mt * 4 + (nt >> 1)) * 64 + kq * 16 + r16) * 8 + 4 * (nt & 1))) = o; } } }
#pragma unroll 1
          for (int mt = 8; mt < 12; ++mt) { bf16x8 af[2];
#pragma unroll
            for (int ks = 0; ks < 2; ++ks) af[ks] = *(const LAS bf16x8*)(LM + (16 * mt + r16) * 72 + 32 * ks + 8 * kq);
            const int i = 16 * (mt - 8) + r16;
#pragma unroll
            for (int n2 = 0; n2 < 2; ++n2) { const int nt = 2 * w + n2; f32x4 d = (f32x4){0.f, 0.f, 0.f, 0.f};
#pragma unroll
                for (int ks = 0; ks < 2; ++ks) d = MFMA16(bfr[n2][ks], af[ks], d);
                if (w < 4) { const int dkc = 16 * nt + 4 * kq; const v2u qv = *(const LAS v2u*)(Qn + i * 136 + dkc); const float gi = gam[i];
                    v2u o; o.x = pk2(gi * bflo(qv.x) - d[0], gi * bfhi(qv.x) - d[1]); o.y = pk2(gi * bflo(qv.y) - d[2], gi * bfhi(qv.y) - d[3]);
                    *(v2u*)(QE + i * 128 + dkc) = o; }
                else { const int dv = 16 * (nt - 8) + 4 * kq; v2u o; o.x = pk2(d[0], d[1]); o.y = pk2(d[2], d[3]);
                    *(v2u*)(OU + i * 128 + dv) = o; } } } }
        __syncthreads();
    }
}

template <int LEVEL>
__device__ __forceinline__ void gdn_seg(Frame& F, int hh, int sc, int half) {
    LAS unsigned char* L = F.lds; const int tid = F.tid, lane = F.lane, w = F.wave, r16 = lane & 15, kq = lane >> 4;
    LAS float* decs = (LAS float*)(L + MISC_OFF + 1024);
    const bool compute = (LEVEL == 1) || (w < 4), storing = (LEVEL != 1) && (w < 4), hasB = (LEVEL == 1) ? (w >= 4) : (w < 4);
    const size_t u0 = LEVEL == 2 ? (size_t)hh * 16 : (size_t)hh * 256 + 16 * sc;
    const bf16* AP = (LEVEL == 2 ? W_GAP2 : W_GAP) + u0 * 16384;
    const bf16* BT = (LEVEL == 2 ? W_GBT2 : W_GBT) + u0 * 16384 + half * 8192;
    const int lt = w & 3, nt = 4 * half + lt;
    if (LEVEL != 2 && tid < 16) decs[tid] = W_GDEC[hh * 256 + 16 * sc + tid];
    f32x4 acc[8];
#pragma unroll
    for (int t = 0; t < 8; ++t) acc[t] = (f32x4){0.f, 0.f, 0.f, 0.f};
    if (LEVEL == 1 && w < 4) {
#pragma unroll
        for (int t = 0; t < 8; ++t)
#pragma unroll
            for (int j = 0; j < 4; ++j) acc[t][j] = (16 * t + 4 * kq + j == 16 * nt + r16) ? 1.0f : 0.0f; }
    if (LEVEL == 3 && compute) { const bf16* S0 = W_GST2 + ((size_t)hh * 16 + sc) * 16384 + (size_t)(16 * nt + r16) * 128 + 4 * kq;
#pragma unroll
        for (int t = 0; t < 8; ++t) { const v2u v = *(const v2u*)(S0 + 16 * t); acc[t] = (f32x4){bflo(v.x), bfhi(v.x), bflo(v.y), bfhi(v.y)}; } }
#define GS_DMA(c) do { const int c_ = (c) < 15 ? (c) : 15; LAS unsigned char* s_ = L + ((c) % 3) * 49152; _Pragma("unroll") for (int i_ = 0; i_ < 4; ++i_) \
        __builtin_amdgcn_global_load_lds((const unsigned*)(AP + (size_t)c_ * 16384 + (i_ * 8 + w) * 512 + lane * 8), (LAS unsigned*)(s_ + (i_ * 8 + w) * 1024), 16, 0, 0); \
        _Pragma("unroll") for (int i_ = 0; i_ < 2; ++i_) \
        __builtin_amdgcn_global_load_lds((const unsigned*)(BT + (size_t)c_ * 16384 + (i_ * 8 + w) * 512 + lane * 8), (LAS unsigned*)(s_ + 32768 + (i_ * 8 + w) * 1024), 16, 0, 0); } while (0)
    asm volatile("s_waitcnt vmcnt(0)" ::: "memory");
    GS_DMA(0); GS_DMA(1);
    __syncthreads();
#pragma unroll 1
    for (int i = 0; i < 16; ++i) {
        if (storing && i > 0) asm volatile("s_waitcnt vmcnt(14)" ::: "memory"); else asm volatile("s_waitcnt vmcnt(6)" ::: "memory");
        __builtin_amdgcn_s_barrier(); asm volatile("" ::: "memory");
        GS_DMA(i + 2);
        if (compute) {
            bf16x8 Sb[4]; unsigned pk_[8][2];
#pragma unroll
            for (int t = 0; t < 8; ++t) { pk_[t][0] = pg8::cvt_pk_bf16(acc[t][0], acc[t][1]); pk_[t][1] = pg8::cvt_pk_bf16(acc[t][2], acc[t][3]); }
            if (LEVEL != 1) { bf16* ST = (LEVEL == 2 ? W_GST2 + ((size_t)hh * 16 + i) * 16384 : W_GST + ((size_t)hh * 256 + 16 * sc + i) * 16384) + (size_t)(16 * nt + r16) * 128 + 4 * kq;
#pragma unroll
                for (int t = 0; t < 8; ++t) { v2u o_; o_.x = pk_[t][0]; o_.y = pk_[t][1]; *(v2u*)(ST + 16 * t) = o_; } }
#pragma unroll
            for (int s = 0; s < 4; ++s) { v4u q_; q_.x = pk_[2 * s][0]; q_.y = pk_[2 * s][1]; q_.z = pk_[2 * s + 1][0]; q_.w = pk_[2 * s + 1][1]; Sb[s] = __builtin_bit_cast(bf16x8, q_); }
            const float dc = LEVEL == 2 ? 0.f : decs[i];
#pragma unroll
            for (int t = 0; t < 8; ++t) acc[t] = acc[t] * dc;
            const LAS unsigned char* slot = L + (i % 3) * 49152 + lane * 16;
#pragma unroll
            for (int s = 0; s < 4; ++s) { bf16x8 fa[8];
#pragma unroll
                for (int t = 0; t < 8; ++t) fa[t] = *(const LAS bf16x8*)(slot + (t * 4 + s) * 1024);
#pragma unroll
                for (int t = 0; t < 8; ++t) acc[t] = MFMA16(fa[t], Sb[s], acc[t]); }
            if (hasB) {
#pragma unroll
                for (int i4 = 0; i4 < 4; ++i4) { const v4u bv = *(const LAS v4u*)(slot + 32768 + (lt * 4 + i4) * 1024);
                    acc[2 * i4][0] += bflo(bv.x); acc[2 * i4][1] += bfhi(bv.x); acc[2 * i4][2] += bflo(bv.y); acc[2 * i4][3] += bfhi(bv.y);
                    acc[2 * i4 + 1][0] += bflo(bv.z); acc[2 * i4 + 1][1] += bfhi(bv.z); acc[2 * i4 + 1][2] += bflo(bv.w); acc[2 * i4 + 1][3] += bfhi(bv.w); } }
        }
    }
    asm volatile("s_waitcnt vmcnt(0)" ::: "memory");
    if (LEVEL == 1) {
        bf16* A2 = W_GAP2 + ((size_t)hh * 16 + sc) * 16384; bf16* B2 = W_GBT2 + ((size_t)hh * 16 + sc) * 16384;
        if (w < 4) {
#pragma unroll
            for (int t = 0; t < 8; ++t)
#pragma unroll
                for (int j = 0; j < 4; ++j) A2[((t * 4 + (nt >> 1)) * 64 + (r16 >> 2) * 16 + 4 * kq + j) * 8 + 4 * (nt & 1) + (r16 & 3)] = (bf16)f2bf(acc[t][j]);
        } else {
#pragma unroll
            for (int t = 0; t < 8; ++t) { v2u o_; o_.x = pk2(acc[t][0], acc[t][1]); o_.y = pk2(acc[t][2], acc[t][3]); *(v2u*)(B2 + ((nt * 4 + (t >> 1)) * 64 + lane) * 8 + 4 * (t & 1)) = o_; } } }
    __syncthreads();
#undef GS_DMA
}

__device__ __forceinline__ void gdn_phase_z(Frame& F, int l) {
    const int lane = F.lane, r16 = lane & 15, kq = lane >> 4, gw = F.vcu * NWAVES + F.wave, NGW = F.G * NWAVES;
    for (int wu = gw; wu < 4096; wu += NGW) { const int u = wu >> 2, mt = wu & 3, hh = u >> 8, ch = u & 255, tok = ch * 64 + 16 * mt + r16;
        const bf16* QE = W_GQE + (size_t)u * 8192 + (16 * mt + r16) * 128 + 8 * kq; const bf16* ST = W_GST + (size_t)u * 16384 + r16 * 128 + 8 * kq;
        bf16x8 qf[4];
#pragma unroll
        for (int s = 0; s < 4; ++s) qf[s] = *(const bf16x8*)(QE + 32 * s);
        bf16x8 sfr[8][4]; v2u our[8];
#pragma unroll
        for (int nt = 0; nt < 8; ++nt) {
#pragma unroll
            for (int s = 0; s < 4; ++s) sfr[nt][s] = *(const bf16x8*)(ST + nt * 16 * 128 + 32 * s);
            our[nt] = *(const v2u*)(W_GOU + (size_t)u * 8192 + (16 * mt + r16) * 128 + 16 * nt + 4 * kq); }
        f32x4 o[8]; float ss = 0.f;
#pragma unroll
        for (int nt = 0; nt < 8; ++nt) { f32x4 d = (f32x4){0.f, 0.f, 0.f, 0.f};
#pragma unroll
            for (int s = 0; s < 4; ++s) d = MFMA16(sfr[nt][s], qf[s], d);
            const v2u ou = our[nt];
            d[0] += bflo(ou.x); d[1] += bfhi(ou.x); d[2] += bflo(ou.y); d[3] += bfhi(ou.y);
            ss += (d[0] * d[0] + d[1] * d[1]) + (d[2] * d[2] + d[3] * d[3]); o[nt] = d; }
        ss += __shfl_xor(ss, 16); ss += __shfl_xor(ss, 32);
        const float rs = rsqrtf(ss * (1.0f / 128.0f) + EPS);
#pragma unroll
        for (int nt = 0; nt < 8; ++nt) { const int dv = 16 * nt + 4 * kq; const f32x4 gn = *(const f32x4*)(P_gdn_norm + l * 128 + dv);
            const v2u gt = *(const v2u*)(W_PROJ + (size_t)tok * NPROJ + C_GGATE + hh * 128 + dv);
            v2u y; y.x = pk2(o[nt][0] * rs * gn[0] * silu_f(bflo(gt.x)), o[nt][1] * rs * gn[1] * silu_f(bfhi(gt.x))); y.y = pk2(o[nt][2] * rs * gn[2] * silu_f(bflo(gt.y)), o[nt][3] * rs * gn[3] * silu_f(bfhi(gt.y)));
            *(v2u*)(W_YBR + (size_t)2 * SEQ * 512 + (size_t)tok * 512 + hh * 128 + dv) = y; }
    }
}


__device__ __forceinline__ void ssd_phase_c(Frame& F, int l) {
    LAS unsigned char* L = F.lds;
    LAS bf16* BTr = (LAS bf16*)L;
    LAS bf16* XWT = (LAS bf16*)(L + 34816);
    LAS float* acum = (LAS float*)(L + 104448); LAS float* dtv = acum + 512; LAS float* wgt = dtv + 512;
    const int tid = F.tid, lane = F.lane, w = F.wave, r16 = lane & 15, kq = lane >> 4;
    const float* cw = P_ssm_conv_w + (size_t)l * 4 * 1024; const float* cb = P_ssm_conv_b + (size_t)l * 1024;
    for (int u = F.vcu; u < 256; u += F.G) { const int c = u >> 1, g = u & 1, t0 = c * 128;
        if (w < 4) { const int h = 4 * g + w; const float bias = P_ssm_dt_bias[l * 8 + h], A = -__expf(P_ssm_a_log[l * 8 + h]);
            const float d0 = softplus_f(W_SMALL[(size_t)(t0 + 2 * lane) * 16 + h] + bias), d1 = softplus_f(W_SMALL[(size_t)(t0 + 2 * lane + 1) * 16 + h] + bias);
            const float a0 = A * d0, a1 = a0 + A * d1; float inc = a1;
#pragma unroll
            for (int o = 1; o < 64; o <<= 1) { const float v = __shfl_up(inc, o); if (lane >= o) inc += v; }
            const float ex = inc - a1, c0v = ex + a0, c1v = ex + a1, al = __shfl(inc, 63);
            acum[w * 128 + 2 * lane] = c0v; acum[w * 128 + 2 * lane + 1] = c1v; dtv[w * 128 + 2 * lane] = d0; dtv[w * 128 + 2 * lane + 1] = d1;
            wgt[w * 128 + 2 * lane] = __expf(al - c0v); wgt[w * 128 + 2 * lane + 1] = __expf(al - c1v);
            W_ACUM[(size_t)(t0 + 2 * lane) * 8 + h] = c0v; W_ACUM[(size_t)(t0 + 2 * lane + 1) * 8 + h] = c1v;
            if (lane == 63) W_SDEC[c * 8 + h] = __expf(al); }
        __syncthreads();
        { const int c16 = tid & 15, tq = tid >> 4;
#pragma unroll 1
          for (int k = 0; k < 4; ++k) { const int ch0 = (k < 2 ? g * 256 + 128 * k : (k == 2 ? 512 + g * 128 : 768 + g * 128)) + 8 * c16;
            f32x4 wv[4][2]; const f32x4 b0 = *(const f32x4*)(cb + ch0), b1 = *(const f32x4*)(cb + ch0 + 4);
#pragma unroll
            for (int i = 0; i < 4; ++i) { wv[i][0] = *(const f32x4*)(cw + i * 1024 + ch0); wv[i][1] = *(const f32x4*)(cw + i * 1024 + ch0 + 4); }
            const int hl = 2 * k + (c16 >> 3), p0 = 8 * (c16 & 7);
#pragma unroll
            for (int th = 0; th < 2; ++th) {
            v4u xra[2][4];
#pragma unroll
            for (int tp = 0; tp < 2; ++tp)
#pragma unroll
                for (int i = 0; i < 4; ++i) { const int ts = t0 + tq + 32 * (2 * th + tp) - 3 + i; xra[tp][i] = *(const v4u*)(W_PROJ + (size_t)(ts < 0 ? 0 : ts) * NPROJ + C_XBC + ch0); }
#pragma unroll
            for (int tp2 = 0; tp2 < 2; ++tp2) { const int t = tq + 32 * (2 * th + tp2); v4u xr[4];
#pragma unroll
                for (int i = 0; i < 4; ++i) xr[i] = xra[tp2][i];
                float a[8] = {b0[0], b0[1], b0[2], b0[3], b1[0], b1[1], b1[2], b1[3]};
#pragma unroll
                for (int i = 0; i < 4; ++i) { const float msk = (t0 + t - 3 + i) < 0 ? 0.f : 1.f; float xv[8]; unpack8(xr[i], xv);
#pragma unroll
                    for (int e = 0; e < 4; ++e) { a[e] += wv[i][0][e] * msk * xv[e]; a[4 + e] += wv[i][1][e] * msk * xv[4 + e]; } }
                v4u o;
#pragma unroll
                for (int e = 0; e < 8; ++e) a[e] = silu_f(a[e]);
                o.x = pk2(a[0], a[1]); o.y = pk2(a[2], a[3]); o.z = pk2(a[4], a[5]); o.w = pk2(a[6], a[7]);
                *(v4u*)(W_XBCB + (size_t)(t0 + t) * 1024 + ch0) = o;
                float ar[8]; unpack8(o, ar);
                if (k < 2) { const float sc = dtv[hl * 128 + t] * wgt[hl * 128 + t];
#pragma unroll
                    for (int e = 0; e < 8; ++e) { const int row = hl * 64 + p0 + e; XWT[row * 136 + (t ^ (((row >> 3) & 15) << 3))] = (bf16)f2bf(ar[e] * sc); } }
                else if (k == 2) {
#pragma unroll
                    for (int e = 0; e < 8; ++e) { const int row = 8 * c16 + e; BTr[row * 136 + (t ^ (((row >> 3) & 15) << 3))] = (bf16)f2bf(ar[e]); } } } asm volatile("" ::: "memory"); } } }
        __syncthreads();
        { const int hl = w >> 1, h = 4 * g + hl;
#pragma unroll 1
          for (int n4 = 0; n4 < 4; ++n4) { const int nt = 4 * (w & 1) + n4; bf16x8 af[4];
#pragma unroll
            for (int ks = 0; ks < 4; ++ks) { const int row = 16 * nt + r16; af[ks] = *(const LAS bf16x8*)(BTr + row * 136 + 8 * ((4 * ks + kq) ^ ((row >> 3) & 15))); }
#pragma unroll
            for (int pt = 0; pt < 4; ++pt) { f32x4 d = (f32x4){0.f, 0.f, 0.f, 0.f};
#pragma unroll
                for (int ks = 0; ks < 4; ++ks) { const int row = hl * 64 + 16 * pt + r16; const bf16x8 bfv = *(const LAS bf16x8*)(XWT + row * 136 + 8 * ((4 * ks + kq) ^ ((row >> 3) & 15))); d = MFMA16(af[ks], bfv, d); }
                *(f32x4*)(W_SST + (((size_t)c * 8 + h) * 64 + 16 * pt + r16) * 128 + 16 * nt + 4 * kq) = d; } } }
        __syncthreads();
    }
}
__device__ __forceinline__ void ssd_scan(Frame& F) {
    const int e4 = F.vcu * 512 + F.tid, h = e4 >> 11; f32x4 hc = (f32x4){0.f, 0.f, 0.f, 0.f};
#pragma unroll 1
    for (int cb = 0; cb < 128; cb += 16) { f32x4 s[16]; float dc[16];
#pragma unroll
        for (int k = 0; k < 16; ++k) { s[k] = *(const f32x4*)(W_SST + (size_t)(cb + k) * 65536 + 4 * e4); dc[k] = W_SDEC[(cb + k) * 8 + h]; }
#pragma unroll
        for (int k = 0; k < 16; ++k) { v2u o; o.x = pk2(hc[0], hc[1]); o.y = pk2(hc[2], hc[3]); *(v2u*)(W_SHIN + (size_t)(cb + k) * 65536 + 4 * e4) = o;
            hc = hc * dc[k] + s[k]; } }
}
__device__ __forceinline__ void ssd_phase_e(Frame& F, int l, int ufirst, int uend, int ustride) {
    LAS unsigned char* L = F.lds;
    LAS bf16* Bs = (LAS bf16*)L;
    LAS bf16* XDT = (LAS bf16*)(L + 34816);
    LAS float* acum = (LAS float*)(L + 104448);
    const int tid = F.tid, lane = F.lane, w = F.wave, r16 = lane & 15, kq = lane >> 4;
    for (int u = ufirst; u < uend; u += ustride) { const int c = u >> 1, g = u & 1, t0 = c * 128;
        LAS float* dts = acum + 512;
        { const int t = tid & 127, hl = tid >> 7, h = 4 * g + hl;
          acum[hl * 128 + t] = W_ACUM[(size_t)(t0 + t) * 8 + h]; dts[hl * 128 + t] = softplus_f(W_SMALL[(size_t)(t0 + t) * 16 + h] + P_ssm_dt_bias[l * 8 + h]); }
        { const int c16 = tid & 15, tq = tid >> 4;
#pragma unroll
          for (int tp = 0; tp < 4; ++tp) { const int t = tq + 32 * tp; *(LAS v4u*)(Bs + t * 136 + 8 * c16) = *(const v4u*)(W_XBCB + (size_t)(t0 + t) * 1024 + 512 + g * 128 + 8 * c16); } }
        __syncthreads();
        { const int c32 = tid & 31, tq = tid >> 5, hl = c32 >> 3, p0 = 8 * (c32 & 7);
#pragma unroll 2
          for (int tp = 0; tp < 8; ++tp) { const int t = tq + 16 * tp; float xv[8]; unpack8(*(const v4u*)(W_XBCB + (size_t)(t0 + t) * 1024 + g * 256 + 8 * c32), xv);
              const float dt = dts[hl * 128 + t];
              const int tpm = (t & ~31) + 8 * ((t >> 2) & 3) + 4 * ((t >> 4) & 1) + (t & 3);
#pragma unroll
              for (int e = 0; e < 8; ++e) { const int row = hl * 64 + p0 + e; XDT[row * 136 + (tpm ^ (((row >> 3) & 15) << 3))] = (bf16)f2bf(xv[e] * dt); } } }
        __syncthreads();
        { const int tl = 16 * w + r16, tok = t0 + tl;
          bf16x8 cf[4];
#pragma unroll
          for (int ks = 0; ks < 4; ++ks) cf[ks] = *(const bf16x8*)(W_XBCB + (size_t)tok * 1024 + 768 + g * 128 + 32 * ks + 8 * kq);
          f32x4 gt[8];
#pragma unroll
          for (int st = 0; st < 8; ++st) { f32x4 d = (f32x4){0.f, 0.f, 0.f, 0.f};
              if (st <= w) {
#pragma unroll
                  for (int ks = 0; ks < 4; ++ks) { const bf16x8 a = *(const LAS bf16x8*)(Bs + (16 * st + r16) * 136 + 32 * ks + 8 * kq); d = MFMA16(a, cf[ks], d); } }
              gt[st] = d; }
          float ss = 0.f;
#pragma unroll 1
          for (int hl = 0; hl < 4; ++hl) { const int h = 4 * g + hl; const float al = acum[hl * 128 + tl];
              f32x4 yd[4], yo[4];
#pragma unroll
              for (int pt = 0; pt < 4; ++pt) { yd[pt] = (f32x4){0.f, 0.f, 0.f, 0.f}; yo[pt] = (f32x4){0.f, 0.f, 0.f, 0.f}; }
#pragma unroll
              for (int k2 = 0; k2 < 4; ++k2) { if (2 * k2 <= w) {
                  v4u sp;
#pragma unroll
                  for (int a = 0; a < 2; ++a) { const int s0 = 32 * k2 + 16 * a + 4 * kq; const f32x4 as = *(const LAS f32x4*)(acum + hl * 128 + s0); float v[4];
#pragma unroll
                      for (int b = 0; b < 4; ++b) v[b] = (s0 + b <= tl) ? gt[2 * k2 + a][b] * __expf(al - as[b]) : 0.f;
                      if (a == 0) { sp.x = pk2(v[0], v[1]); sp.y = pk2(v[2], v[3]); } else { sp.z = pk2(v[0], v[1]); sp.w = pk2(v[2], v[3]); } }
                  const bf16x8 sf = __builtin_bit_cast(bf16x8, sp);
#pragma unroll
                  for (int pt = 0; pt < 4; ++pt) { const int row = hl * 64 + 16 * pt + r16; const bf16x8 xa = *(const LAS bf16x8*)(XDT + row * 136 + 8 * ((4 * k2 + kq) ^ ((row >> 3) & 15))); yd[pt] = MFMA16(xa, sf, yd[pt]); } } }
              const bf16* hin = W_SHIN + (((size_t)c * 8 + h) * 64 + r16) * 128 + 8 * kq;
              { bf16x8 hfr[4][4];
#pragma unroll
                for (int pt = 0; pt < 4; ++pt)
#pragma unroll
                    for (int ks = 0; ks < 4; ++ks) hfr[pt][ks] = *(const bf16x8*)(hin + pt * 16 * 128 + 32 * ks);
#pragma unroll
                for (int pt = 0; pt < 4; ++pt)
#pragma unroll
                    for (int ks = 0; ks < 4; ++ks) yo[pt] = MFMA16(hfr[pt][ks], cf[ks], yo[pt]); }
              const float eal = __expf(al), Dh = P_ssm_d[l * 8 + h];
#pragma unroll
              for (int pt = 0; pt < 4; ++pt) { const int ch = g * 256 + hl * 64 + 16 * pt + 4 * kq;
                  const v2u xr = *(const v2u*)(W_XBCB + (size_t)tok * 1024 + ch); const v2u zr = *(const v2u*)(W_PROJ + (size_t)tok * NPROJ + C_Z + ch);
                  f32x4 y = yd[pt] + eal * yo[pt]; y[0] += Dh * bflo(xr.x); y[1] += Dh * bfhi(xr.x); y[2] += Dh * bflo(xr.y); y[3] += Dh * bfhi(xr.y);
                  y[0] *= silu_f(bflo(zr.x)); y[1] *= silu_f(bfhi(zr.x)); y[2] *= silu_f(bflo(zr.y)); y[3] *= silu_f(bfhi(zr.y));
                  v2u o; o.x = pk2(y[0], y[1]); o.y = pk2(y[2], y[3]);
                  ss += (bflo(o.x) * bflo(o.x) + bfhi(o.x) * bfhi(o.x)) + (bflo(o.y) * bflo(o.y) + bfhi(o.y) * bfhi(o.y));
                  *(v2u*)(W_YBR + (size_t)tok * 512 + ch) = o; } }
          ss += __shfl_xor(ss, 16); ss += __shfl_xor(ss, 32);
          const float rs = rsqrtf(ss * (1.0f / 256.0f) + EPS);
#pragma unroll
          for (int hl = 0; hl < 4; ++hl)
#pragma unroll
              for (int pt = 0; pt < 4; ++pt) { const int ch = g * 256 + hl * 64 + 16 * pt + 4 * kq; const f32x4 gn = *(const f32x4*)(P_ssm_norm + l * 512 + ch);
                  const v2u yv = *(const v2u*)(W_YBR + (size_t)tok * 512 + ch);
                  v2u o; o.x = pk2(bflo(yv.x) * rs * gn[0], bfhi(yv.x) * rs * gn[1]); o.y = pk2(bflo(yv.y) * rs * gn[2], bfhi(yv.y) * rs * gn[3]);
                  *(v2u*)(W_YBR + (size_t)tok * 512 + ch) = o; } }
        __syncthreads();
    }
}


__device__ __forceinline__ void sb_mfma_unit(Frame& F, int l, int hh, int qb) {
    LAS bf16* Ks = (LAS bf16*)F.lds;
    LAS bf16* VT = Ks + 64 * 136;
    LAS float* red = (LAS float*)(F.lds + 35840);
    const int tid = F.tid, lane = F.lane, w = F.wave, r16 = lane & 15, kq = lane >> 4, q0 = qb * 128, tg = q0 + 16 * w + r16;
    bf16x8 qf[4];
    { const bf16* qp = W_PROJ + (size_t)tg * NPROJ + C_SBQKV + hh * 128 + 8 * kq; float qv[4][8]; float ss = 0.f;
#pragma unroll
      for (int ks = 0; ks < 4; ++ks) { unpack8(*(const v4u*)(qp + 32 * ks), qv[ks]);
#pragma unroll
          for (int e = 0; e < 8; ++e) ss += qv[ks][e] * qv[ks][e]; }
      ss += __shfl_xor(ss, 16); ss += __shfl_xor(ss, 32);
      const float rs = rsqrtf(ss * (1.0f / 128.0f) + EPS) * 0.08838834764831845f; const float* qg = P_sb_q_norm + l * 128 + 8 * kq;
#pragma unroll
      for (int ks = 0; ks < 4; ++ks) { v4u p; p.x = pk2(qv[ks][0] * rs * qg[32 * ks], qv[ks][1] * rs * qg[32 * ks + 1]); p.y = pk2(qv[ks][2] * rs * qg[32 * ks + 2], qv[ks][3] * rs * qg[32 * ks + 3]);
          p.z = pk2(qv[ks][4] * rs * qg[32 * ks + 4], qv[ks][5] * rs * qg[32 * ks + 5]); p.w = pk2(qv[ks][6] * rs * qg[32 * ks + 6], qv[ks][7] * rs * qg[32 * ks + 7]); qf[ks] = __builtin_bit_cast(bf16x8, p); } }
    f32x4 oacc[8];
#pragma unroll
    for (int i = 0; i < 8; ++i) oacc[i] = (f32x4){0.f, 0.f, 0.f, 0.f};
    float accrow = 0.f;
    v4u kraw[2], vraw[2];
    { const bf16* kp = W_PROJ + (size_t)(64 * (2 * qb + 1) + (tid >> 3)) * NPROJ + C_SBQKV + 512 + hh * 128 + 16 * (tid & 7);
      kraw[0] = *(const v4u*)kp; kraw[1] = *(const v4u*)(kp + 8); vraw[0] = *(const v4u*)(kp + 512); vraw[1] = *(const v4u*)(kp + 520); }
    for (int jb = 2 * qb + 1; jb >= 0; --jb) {
        { const int kr = tid >> 3, k8 = tid & 7; float kv[16]; float ss = 0.f;
          const v4u v0 = vraw[0], v1 = vraw[1];
          unpack8(kraw[0], kv); unpack8(kraw[1], kv + 8);
#pragma unroll
          for (int e = 0; e < 16; ++e) ss += kv[e] * kv[e];
          ss += __shfl_xor(ss, 1); ss += __shfl_xor(ss, 2); ss += __shfl_xor(ss, 4);
          const float rk = rsqrtf(ss * (1.0f / 128.0f) + EPS); const float* kg = P_sb_k_norm + l * 128 + 16 * k8;
          v4u o0, o1; o0.x = pk2(kv[0] * rk * kg[0], kv[1] * rk * kg[1]); o0.y = pk2(kv[2] * rk * kg[2], kv[3] * rk * kg[3]); o0.z = pk2(kv[4] * rk * kg[4], kv[5] * rk * kg[5]); o0.w = pk2(kv[6] * rk * kg[6], kv[7] * rk * kg[7]);
          o1.x = pk2(kv[8] * rk * kg[8], kv[9] * rk * kg[9]); o1.y = pk2(kv[10] * rk * kg[10], kv[11] * rk * kg[11]); o1.z = pk2(kv[12] * rk * kg[12], kv[13] * rk * kg[13]); o1.w = pk2(kv[14] * rk * kg[14], kv[15] * rk * kg[15]);
          *(LAS v4u*)(Ks + kr * 136 + 16 * k8) = o0; *(LAS v4u*)(Ks + kr * 136 + 16 * k8 + 8) = o1;
          const int sp = (kr & ~31) + 8 * ((kr >> 2) & 3) + 4 * ((kr >> 4) & 1) + (kr & 3);
          const unsigned vw[8] = {v0.x, v0.y, v0.z, v0.w, v1.x, v1.y, v1.z, v1.w};
#pragma unroll
          for (int e = 0; e < 8; ++e) { VT[(16 * k8 + 2 * e) * 72 + sp] = (bf16)(vw[e] & 0xffffu); VT[(16 * k8 + 2 * e + 1) * 72 + sp] = (bf16)(vw[e] >> 16); } }
        __syncthreads();
        if (jb > 0) { const bf16* kp = W_PROJ + (size_t)(64 * (jb - 1) + (tid >> 3)) * NPROJ + C_SBQKV + 512 + hh * 128 + 16 * (tid & 7);
            kraw[0] = *(const v4u*)kp; kraw[1] = *(const v4u*)(kp + 8); vraw[0] = *(const v4u*)(kp + 512); vraw[1] = *(const v4u*)(kp + 520); }
        if (64 * jb <= q0 + 16 * w + 15) {
            f32x4 st[4];
#pragma unroll
            for (int i = 0; i < 4; ++i) { f32x4 d = (f32x4){0.f, 0.f, 0.f, 0.f};
#pragma unroll
                for (int ks = 0; ks < 4; ++ks) { const bf16x8 a = *(const LAS bf16x8*)(Ks + (16 * i + r16) * 136 + 32 * ks + 8 * kq); d = MFMA16(a, qf[ks], d); }
                st[i] = d; }
            float carry = accrow; unsigned pw[4][2];
#pragma unroll
            for (int i = 3; i >= 0; --i) { float lb[4], lk[4];
#pragma unroll
                for (int j = 0; j < 4; ++j) { const float z = st[i][j]; const bool valid = (64 * jb + 16 * i + 4 * kq + j) < tg;
                    const float b = fminf(z, 0.f) - __logf(1.0f + __expf(-fabsf(z))); lb[j] = valid ? b : -INFINITY; lk[j] = valid ? b - z : 0.f; }
                const float q = (lk[0] + lk[1]) + (lk[2] + lk[3]);
                const float v1 = __shfl_xor(q, 16), v2 = __shfl_xor(q, 32), v3 = __shfl_xor(v1, 32);
                const float hi = kq == 0 ? (v1 + v2 + v3) : (kq == 1 ? (v2 + v3) : (kq == 2 ? v1 : 0.f));
                const float base = carry + hi;
                const float p3 = __expf(lb[3] + base), p2 = __expf(lb[2] + base + lk[3]), p1 = __expf(lb[1] + base + lk[3] + lk[2]), p0 = __expf(lb[0] + base + lk[3] + lk[2] + lk[1]);
                pw[i][0] = pk2(p0, p1); pw[i][1] = pk2(p2, p3);
                carry += (q + v1) + (v2 + v3); }
            accrow = carry;
#pragma unroll
            for (int k2 = 0; k2 < 2; ++k2) { v4u pp; pp.x = pw[2 * k2][0]; pp.y = pw[2 * k2][1]; pp.z = pw[2 * k2 + 1][0]; pp.w = pw[2 * k2 + 1][1]; const bf16x8 pf = __builtin_bit_cast(bf16x8, pp);
#pragma unroll
                for (int dt = 0; dt < 8; ++dt) { const bf16x8 a = *(const LAS bf16x8*)(VT + (16 * dt + r16) * 72 + 32 * k2 + 8 * kq); oacc[dt] = MFMA16(a, pf, oacc[dt]); } }
        }
        float mx = accrow;
#pragma unroll
        for (int of = 1; of < 64; of <<= 1) mx = fmaxf(mx, __shfl_xor(mx, of));
        if (lane == 0) red[w] = mx;
        __syncthreads();
        float m = red[0];
#pragma unroll
        for (int i = 1; i < 8; ++i) m = fmaxf(m, red[i]);
        if (m < -104.0f) break;
    }
    bf16* op = W_YBR + (size_t)SEQ * 512 + (size_t)tg * 512 + hh * 128 + 4 * kq;
#pragma unroll
    for (int dt = 0; dt < 8; ++dt) { v2u o; o.x = pk2(oacc[dt][0], oacc[dt][1]); o.y = pk2(oacc[dt][2], oacc[dt][3]); *(v2u*)(op + 16 * dt) = o; }
    __syncthreads();
}
__device__ __forceinline__ void phase_mix1(Frame& F, int l) {
    if (F.vcu < 32) ssd_scan(F);
    else if (F.vcu < 160) { const int u = F.vcu - 32; gdn_seg<1>(F, u >> 5, (u >> 1) & 15, u & 1); }
    LAS int* nxt = (LAS int*)(F.lds + MISC_OFF + 512);
    for (;;) {
        __syncthreads();
        if (F.tid == 0) *nxt = (int)atomicAdd(F.ctl + CW_SBQ + l * 64, 1u);
        __syncthreads();
        const int u = *nxt; if (u >= 512) break;
        sb_mfma_unit(F, l, u & 3, 127 - (u >> 2));
    }
}
__device__ __forceinline__ void phase_mix2(Frame& F, int l) {
    if (F.vcu < 8) gdn_seg<2>(F, F.vcu >> 1, 0, F.vcu & 1);
    else ssd_phase_e(F, l, F.vcu - 8, 248, F.G);
}
__device__ __forceinline__ void phase_mix3(Frame& F, int l) {
    if (F.vcu < 128) gdn_seg<3>(F, F.vcu >> 5, (F.vcu >> 1) & 15, F.vcu & 1);
    else if (F.vcu < 136) ssd_phase_e(F, l, 248 + F.vcu - 128, 256, 8);
}

__device__ __forceinline__ void phase_final(Frame& F) {
    const int lane = F.lane, gw = F.vcu * NWAVES + F.wave, NGW = F.G * NWAVES;
    f32x4 G4[4];
#pragma unroll
    for (int j = 0; j < 4; ++j) G4[j] = modv4<true>(F, NL - 1, 5, j * 256 + 4 * lane);
    LAS int* ttab = (LAS int*)(F.lds + MISC_OFF + 3072); build_tile_table(F, NL - 1, ttab);
    for (int m = gw; m < SEQ; m += NGW) {
        const int s0 = ttab[W_PAIRE[2 * m]] * 256 + W_PAIRS[2 * m], s1 = ttab[W_PAIRE[2 * m + 1]] * 256 + W_PAIRS[2 * m + 1]; const float w0 = W_PAIRW[2 * m], w1 = W_PAIRW[2 * m + 1];
        const v2u* y0 = (const v2u*)(W_YP + (size_t)s0 * 1024); const v2u* y1 = (const v2u*)(W_YP + (size_t)s1 * 1024);
#pragma unroll
        for (int j = 0; j < 4; ++j) { const v2u a = y0[64 * j + lane], b = y1[64 * j + lane]; f32x4 v = ((const f32x4*)(F.out + (size_t)m * 1024))[64 * j + lane];
            f32x4 y; y[0] = w0 * bflo(a.x) + w1 * bflo(b.x); y[1] = w0 * bfhi(a.x) + w1 * bfhi(b.x); y[2] = w0 * bflo(a.y) + w1 * bflo(b.y); y[3] = w0 * bfhi(a.y) + w1 * bfhi(b.y);
            ((f32x4*)(F.out + (size_t)m * 1024))[64 * j + lane] = v + G4[j] * y; }
    }
}

struct Args { const float* in[28]; float* out; unsigned char* ws; int ph_lo, ph_hi, li, pad; };
__global__ void __launch_bounds__(NWAVES * 64, 2) mk_fwd(Args args) {
    extern __shared__ __attribute__((aligned(16))) unsigned char lds[];
    Frame F;
    F.lds = (LAS unsigned char*)lds;
    F.tid = threadIdx.x; F.lane = F.tid & 63; F.wave = __builtin_amdgcn_readfirstlane(F.tid >> 6);
    F.G = gridDim.x; { const int bx = blockIdx.x; F.vcu = (F.G % 8 == 0) ? (bx % 8) * (F.G / 8) + bx / 8 : bx; }
    F.ws = args.ws; F.in = args.in; F.out = args.out;
    F.ctl = (unsigned*)(F.ws + WS_CTL);
    volatile LAS unsigned* MISC = (volatile LAS unsigned*)(F.lds + MISC_OFF);
    for (int u = F.tid; u < 128; u += NWAVES * 64) MISC[u] = 0u;
    __syncthreads();
    const int lo = args.ph_lo, hi = args.ph_hi; const int vcu0 = F.vcu;
    XcdBarrier bar; bar.bar = F.ctl + CW_BAR + args.li * XCD_BAR_WORDS; bar.x = 0; bar.st = nullptr;
    if (hi - lo > 1) bar = xcd_barrier_post(F.ctl + CW_BAR + args.li * XCD_BAR_WORDS, MISC + 8);
#define IN(k) (lo <= (k) && (k) < hi)
#define FRESH() do { int t_ = threadIdx.x; asm volatile("" : "+v"(t_)); F.tid = t_; F.lane = t_ & 63; F.wave = __builtin_amdgcn_readfirstlane(t_ >> 6); \
        int v_ = vcu0, g_ = (int)gridDim.x; asm volatile("" : "+s"(v_), "+s"(g_)); F.vcu = v_; F.G = g_; \
        } while (0)
#define SEAM(k) do { if ((k) + 1 < hi) xcd_barrier(bar); } while (0)

    if (IN(0)) { FRESH(); p0_prologue(F); SEAM(0); }
    for (int l = 0; l < NL; ++l) {
        const int pb = 1 + 13 * l;
        if (IN(pb + 0)) { FRESH(); phase_norm<false>(F, l); SEAM(pb + 0); }
        if (IN(pb + 1)) { FRESH();
            pg8::Gemm g{W_HB, W_WIN + (size_t)l * 8192 * 1024, 1024, 0, 0}; pg8::StaticOrder S; S.init(SEQ, 8192, F.G, (int)blockIdx.x);
            pg8::EpiProj E{W_PROJ, NPROJ, C_BRG / 256, W_GATES};
            pg8::gemm_phase(F.lds, g, S, E); SEAM(pb + 1); }
        if (IN(pb + 2)) { FRESH(); gdn_phase_x(F, l); FRESH(); ssd_phase_c(F, l); SEAM(pb + 2); }
        if (IN(pb + 3)) { FRESH(); phase_mix1(F, l); SEAM(pb + 3); }
        if (IN(pb + 4)) { FRESH(); phase_mix2(F, l); SEAM(pb + 4); }
        if (IN(pb + 5)) { FRESH(); phase_mix3(F, l); SEAM(pb + 5); }
        if (IN(pb + 6)) { FRESH(); gdn_phase_z(F, l); SEAM(pb + 6); }
        if (IN(pb + 7)) { FRESH();
            pg8::Gemm g{W_YBR, W_WBR + (size_t)l * 3 * 1024 * 512, 512, (size_t)SEQ * 512 * 2, (size_t)1024 * 512 * 2}; pg8::BranchOrder S; S.so.init(SEQ, 1024, F.G, (int)blockIdx.x);
            pg8::EpiBranch E{W_GATES, W_MERGED};
            pg8::gemm_phase(F.lds, g, S, E); SEAM(pb + 7); }
        if (IN(pb + 8)) { FRESH();
            pg8::Gemm g{W_MERGED, W_WOUT + (size_t)l * 1024 * 1024, 1024, 0, 0}; pg8::StaticOrder S; S.init(SEQ, 1024, F.G, (int)blockIdx.x);
            pg8::EpiOut E{l == 0 ? P_x : F.out, F.out, W_MODF + l * 6144 + 2 * 1024};
            pg8::gemm_phase(F.lds, g, S, E); SEAM(pb + 8); }
        if (IN(pb + 9)) { FRESH(); phase_norm<true>(F, l); SEAM(pb + 9); }
        if (IN(pb + 11)) { FRESH();
            LAS int* tab = (LAS int*)(F.lds + MISC_OFF + 3072); const int nt = build_tile_table(F, l, tab);
            pg8::Gemm g{W_HB, W_WGU + (size_t)l * 32 * 1024 * 1024, 1024, 0, (size_t)1024 * 1024 * 2}; pg8::ExpertOrder S{tab, F.G, F.vcu, nt};
            pg8::EpiAct E{W_ACT}; pg8::Gather GI{W_TOKOF, tab, tab + 64};
            pg8::gemm_phase<pg8::EpiAct, pg8::ExpertOrder, true>(F.lds, g, S, E, GI); SEAM(pb + 11); }
        if (IN(pb + 12)) { FRESH();
            LAS int* tab = (LAS int*)(F.lds + MISC_OFF + 3072); const int nt = build_tile_table(F, l, tab);
            pg8::Gemm g{W_ACT, W_WD + (size_t)l * 32 * 1024 * 512, 512, 0, (size_t)1024 * 512 * 2}; pg8::ExpertOrder S{tab, F.G, F.vcu, nt};
            pg8::EpiBf16 E{W_YP};
            pg8::gemm_phase(F.lds, g, S, E); SEAM(pb + 12); }
    }
    if (IN(53)) { FRESH(); phase_final(F); }
#undef IN
#undef SEAM
}

extern "C" void kernel_launch(void* const* d_in, const int* in_sizes, int n_in, void* d_out, int out_size, void* d_ws, size_t ws_size, hipStream_t stream) {
    static int grid = 0;
    if (grid == 0) {
        if (n_in != 28 || in_sizes[0] != SEQ * DM || out_size != SEQ * DM || ws_size < WS_END) {
            fprintf(stderr, "kernel_launch: built for 28 inputs, x/out of %d floats, >= %zu bytes of workspace; got n_in %d in0 %d out %d ws %zu\n", SEQ * DM, (size_t)WS_END, n_in, n_in > 0 ? in_sizes[0] : -1, out_size, ws_size); grid = -1; return; }
        int dev = 0, cus = 0, per_cu = 0;
        if (hipGetDevice(&dev) != hipSuccess || hipDeviceGetAttribute(&cus, hipDeviceAttributeMultiprocessorCount, dev) != hipSuccess) { fprintf(stderr, "kernel_launch: device query failed\n"); grid = -1; return; }
        if (hipFuncSetAttribute((const void*)mk_fwd, hipFuncAttributeMaxDynamicSharedMemorySize, LDS_BYTES) != hipSuccess) { fprintf(stderr, "kernel_launch: hipFuncSetAttribute failed\n"); grid = -1; return; }
        if (hipOccupancyMaxActiveBlocksPerMultiprocessor(&per_cu, (const void*)mk_fwd, NWAVES * 64, LDS_BYTES) != hipSuccess || per_cu < 1)
            fprintf(stderr, "kernel_launch: occupancy query reports %d workgroups per CU\n", per_cu);
        (void)hipGetLastError();
        grid = cus;
    }
    if (grid < 0) return;
    if (hipMemsetAsync((char*)d_ws + WS_CTL, 0, CTL_ZERO_BYTES, stream) != hipSuccess) { fprintf(stderr, "kernel_launch: memset failed\n"); return; }
    Args a{};
    for (int i = 0; i < 28; ++i) a.in[i] = (const float*)d_in[i];
    a.out = (float*)d_out; a.ws = (unsigned char*)d_ws; a.pad = 0;
#if MK_SPLIT
    for (int p = 0; p < N_PHASES; ++p) { a.ph_lo = p; a.ph_hi = p + 1; a.li = 0;
        hipLaunchKernelGGL(mk_fwd, dim3(grid), dim3(NWAVES * 64), LDS_BYTES, stream, a);
        const hipError_t le = hipPeekAtLastError();
        if (le != hipSuccess) { fprintf(stderr, "kernel_launch: launch %d failed: %s\n", p, hipGetErrorName(le)); break; } }
#else
    a.ph_lo = 0; a.ph_hi = N_PHASES; a.li = 0;
    hipLaunchKernelGGL(mk_fwd, dim3(grid), dim3(NWAVES * 64), LDS_BYTES, stream, a);
    const hipError_t le = hipPeekAtLastError();
    if (le != hipSuccess) fprintf(stderr, "kernel_launch: launch failed: %s\n", hipGetErrorName(le));
#endif
}
```
